# Optimizing an MI355X kernel written in HIP

```python
import math
import jax, jax.numpy as jnp
from jax import lax
import numpy as np

D_MODEL = 2048
BATCH = 4
SEQ = 2048
DEPTH = 2

GRID_W = 64
CTX_LEN = 256
D_FF = 5632
CONV_DIM = 1024
CONV_K = 31
SSM_DIM = 1024
SSM_GROUP = 16
SSM_GROUPS = SSM_DIM // SSM_GROUP
SSM_STATE = 64
N_MOD = 9
N_IN = 2 * CONV_DIM + SSM_DIM + 2 * D_MODEL
CONV_IN_END = 2 * CONV_DIM
SSM_IN_END = 2 * CONV_DIM + SSM_DIM
FFN_RES = 0.5
EPS = 1e-6
DT_MIN = 1e-3
DT_MAX = 1e-1

kernel_name = "hybrid_conformer_s5_dit_prefix"


def rmsnorm(x, g):
    x32 = x.astype(jnp.float32)
    y = x32 * lax.rsqrt(jnp.mean(x32 * x32, axis=-1, keepdims=True) + EPS)
    return (y * g.astype(jnp.float32)).astype(x.dtype)


def layernorm(x, g, b):
    x32 = x.astype(jnp.float32)
    mu = jnp.mean(x32, axis=-1, keepdims=True)
    var = jnp.mean(jnp.square(x32 - mu), axis=-1, keepdims=True)
    y = (x32 - mu) * lax.rsqrt(var + EPS)
    return (y * g.astype(jnp.float32) + b.astype(jnp.float32)).astype(x.dtype)


def modulate(h, shift, scale):
    return h * (1 + scale) + shift


def swiglu(h, w_up, w_down):
    a, g = jnp.split(h @ w_up, 2, axis=-1)
    return (jax.nn.silu(g) * a) @ w_down


def dwconv(u, w, b):
    y = lax.conv_general_dilated(
        u, w[:, None, :], window_strides=(1,),
        padding=[(CONV_K // 2, CONV_K // 2)],
        dimension_numbers=("NWC", "WIO", "NWC"),
        feature_group_count=u.shape[-1])
    return y + b


def conv_grid(u, w, b, rows):
    bn, L, C = u.shape
    half = C // 2
    g = u.reshape(bn, rows, GRID_W, C)
    horiz = dwconv(g[..., :half].reshape(bn * rows, GRID_W, half), w[:, :half], b[:half])
    horiz = horiz.reshape(bn, rows, GRID_W, half)
    vin = g[..., half:].transpose(0, 2, 1, 3).reshape(bn * GRID_W, rows, half)
    vert = dwconv(vin, w[:, half:], b[half:]).reshape(bn, GRID_W, rows, half).transpose(0, 2, 1, 3)
    return jnp.concatenate([horiz, vert], axis=-1).reshape(bn, L, C)


def conv_branch(conv_in, p, conv_fn):
    a, g = jnp.split(conv_in, 2, axis=-1)
    u = a * jax.nn.sigmoid(g)
    u = conv_fn(u)
    u = jax.nn.silu(layernorm(u, p["conv_ln_g"], p["conv_ln_b"]))
    return u @ p["conv_w_out"]


def ssm_discretize(a_re, a_im, log_dt, b_re, b_im):
    lam = lax.complex(a_re.astype(jnp.float32), a_im.astype(jnp.float32))
    dt = jnp.exp(log_dt.astype(jnp.float32))[:, None]
    lam_bar = jnp.exp(lam * dt)
    bmat = lax.complex(b_re.astype(jnp.float32), b_im.astype(jnp.float32))
    b_bar = ((lam_bar - 1) / lam)[..., None] * bmat
    return lam_bar, b_bar


def _lin_combine(left, right):
    a_l, b_l = left
    a_r, b_r = right
    return a_r * a_l, a_r * b_l + b_r


def ssm_scan(lam_bar, b_bar, u, h0, reverse):
    bu = jnp.einsum("gpc,blgc->blgp", b_bar, u.astype(jnp.complex64))
    if h0 is not None:
        idx = -1 if reverse else 0
        bu = bu.at[:, idx].add(lam_bar * h0)
    a = jnp.broadcast_to(lam_bar, bu.shape)
    _, h = lax.associative_scan(_lin_combine, (a, bu), reverse=reverse, axis=1)
    return h


def ssm_readout(hf, hb, cf, cb, u, p):
    bn, L = u.shape[0], u.shape[1]
    y = jnp.real(jnp.einsum("gcp,blgp->blgc", cf, hf) + jnp.einsum("gcp,blgp->blgc", cb, hb))
    y = y.reshape(bn, L, SSM_DIM).astype(u.dtype) + p["ssm_d"] * u
    z = jax.nn.gelu(y) @ p["ssm_w_glu"] + p["ssm_b_glu"]
    a, g = jnp.split(z, 2, axis=-1)
    return a * jax.nn.sigmoid(g)


def ssm_branch(u, uc, p, ctx_out):
    lam_f, bbar_f = ssm_discretize(p["ssm_a_re"][0], p["ssm_a_im"][0], p["ssm_log_dt"][0],
                                   p["ssm_b_re"][0], p["ssm_b_im"][0])
    lam_b, bbar_b = ssm_discretize(p["ssm_a_re"][1], p["ssm_a_im"][1], p["ssm_log_dt"][1],
                                   p["ssm_b_re"][1], p["ssm_b_im"][1])
    cf = lax.complex(p["ssm_c_re"][0].astype(jnp.float32), p["ssm_c_im"][0].astype(jnp.float32))
    cb = lax.complex(p["ssm_c_re"][1].astype(jnp.float32), p["ssm_c_im"][1].astype(jnp.float32))

    def grp(v):
        return v.astype(jnp.float32).reshape(v.shape[0], v.shape[1], SSM_GROUPS, SSM_GROUP)

    ug, ucg = grp(u), grp(uc)
    hcf = ssm_scan(lam_f, bbar_f, ucg, None, False)
    hcb = ssm_scan(lam_b, bbar_b, ucg, None, True)
    hf = ssm_scan(lam_f, bbar_f, ug, hcf[:, -1], False)
    hb = ssm_scan(lam_b, bbar_b, ug, hcb[:, 0], True)
    y = ssm_readout(hf, hb, cf, cb, u, p)
    yc = ssm_readout(hcf, hcb, cf, cb, uc, p) if ctx_out else None
    return y, yc


def mixer(h, hc, p, rows, ctx_out):
    proj = h @ p["w_in"] + p["b_in"]
    conv_in, ssm_in, gate = jnp.split(proj, [CONV_IN_END, SSM_IN_END], axis=-1)
    if ctx_out:
        projc = hc @ p["w_in"] + p["b_in"]
        conv_in_c, ssm_in_c, gate_c = jnp.split(projc, [CONV_IN_END, SSM_IN_END], axis=-1)
    else:
        ssm_in_c = hc @ p["w_in"][:, CONV_IN_END:SSM_IN_END] + p["b_in"][CONV_IN_END:SSM_IN_END]
    y_conv = conv_branch(conv_in, p, lambda v: conv_grid(v, p["conv_dw"], p["conv_db"], rows))
    y_ssm, y_ssm_c = ssm_branch(ssm_in, ssm_in_c, p, ctx_out)
    g_conv, g_ssm = jnp.split(gate, 2, axis=-1)
    y = (jax.nn.sigmoid(g_conv) * y_conv + jax.nn.sigmoid(g_ssm) * y_ssm) @ p["w_out"]
    if ctx_out:
        y_conv_c = conv_branch(conv_in_c, p, lambda v: dwconv(v, p["conv_dw"], p["conv_db"]))
        gc_conv, gc_ssm = jnp.split(gate_c, 2, axis=-1)
        yc = (jax.nn.sigmoid(gc_conv) * y_conv_c + jax.nn.sigmoid(gc_ssm) * y_ssm_c) @ p["w_out"]
    else:
        yc = None
    return y, yc


def layer(x, xc, c, c_ctx, p, rows, ctx_out):
    mod = jax.nn.silu(c)[:, None, :] @ p["ada_w"] + p["ada_b"]
    modc = jax.nn.silu(c_ctx)[None, None, :] @ p["ada_w"] + p["ada_b"]
    sh1, sc1, g1, sh2, sc2, g2, sh3, sc3, g3 = jnp.split(mod, N_MOD, axis=-1)
    csh1, csc1, cg1, csh2, csc2, cg2, csh3, csc3, cg3 = jnp.split(modc, N_MOD, axis=-1)
    x = x + g1 * FFN_RES * swiglu(modulate(rmsnorm(x, p["norm_ffn1"]), sh1, sc1),
                                  p["ffn1_w_up"], p["ffn1_w_down"])
    xc = xc + cg1 * FFN_RES * swiglu(modulate(rmsnorm(xc, p["norm_ffn1"]), csh1, csc1),
                                     p["ffn1_w_up"], p["ffn1_w_down"])
    h = modulate(rmsnorm(x, p["norm_mix"]), sh2, sc2)
    hc = modulate(rmsnorm(xc, p["norm_mix"]), csh2, csc2)
    y, yc = mixer(h, hc, p, rows, ctx_out)
    x = x + g2 * y
    x = x + g3 * FFN_RES * swiglu(modulate(rmsnorm(x, p["norm_ffn2"]), sh3, sc3),
                                  p["ffn2_w_up"], p["ffn2_w_down"])
    if ctx_out:
        xc = xc + cg2 * yc
        xc = xc + cg3 * FFN_RES * swiglu(modulate(rmsnorm(xc, p["norm_ffn2"]), csh3, csc3),
                                         p["ffn2_w_up"], p["ffn2_w_down"])
    else:
        xc = None
    return x, xc


def setup_inputs(seed: int = 0) -> dict:
    key = jax.random.key(seed)
    ks = jax.random.split(key, 40)
    f32 = jnp.float32
    nrm = lambda k, shape, s: jax.random.normal(k, shape, f32) * s
    gain = lambda k, shape: 1.0 + 0.05 * jax.random.normal(k, shape, f32)
    L, G, P, GC = DEPTH, SSM_GROUPS, SSM_STATE, SSM_GROUP
    a_im_base = math.pi * jnp.arange(P, dtype=f32)
    return {
        "x": nrm(ks[0], (BATCH, SEQ, D_MODEL), 1.0),
        "c": nrm(ks[1], (BATCH, D_MODEL), 1.0),
        "ctx": nrm(ks[2], (BATCH, CTX_LEN, D_MODEL), 1.0),
        "c_ctx": nrm(ks[3], (D_MODEL,), 1.0),
        "ada_w": nrm(ks[4], (L, D_MODEL, N_MOD * D_MODEL), 0.5 * D_MODEL ** -0.5),
        "ada_b": nrm(ks[5], (L, N_MOD * D_MODEL), 0.01),
        "norm_ffn1": gain(ks[6], (L, D_MODEL)),
        "ffn1_w_up": nrm(ks[7], (L, D_MODEL, 2 * D_FF), D_MODEL ** -0.5),
        "ffn1_w_down": nrm(ks[8], (L, D_FF, D_MODEL), D_FF ** -0.5),
        "norm_mix": gain(ks[9], (L, D_MODEL)),
        "w_in": nrm(ks[10], (L, D_MODEL, N_IN), D_MODEL ** -0.5),
        "b_in": nrm(ks[11], (L, N_IN), 0.01),
        "conv_dw": nrm(ks[12], (L, CONV_K, CONV_DIM), CONV_K ** -0.5),
        "conv_db": nrm(ks[13], (L, CONV_DIM), 0.01),
        "conv_ln_g": gain(ks[14], (L, CONV_DIM)),
        "conv_ln_b": nrm(ks[15], (L, CONV_DIM), 0.01),
        "conv_w_out": nrm(ks[16], (L, CONV_DIM, D_MODEL), CONV_DIM ** -0.5),
        "ssm_a_re": -0.5 + nrm(ks[17], (L, 2, G, P), 0.01),
        "ssm_a_im": a_im_base + nrm(ks[18], (L, 2, G, P), 0.01),
        "ssm_log_dt": jax.random.uniform(ks[19], (L, 2, G), f32, math.log(DT_MIN), math.log(DT_MAX)),
        "ssm_b_re": nrm(ks[20], (L, 2, G, P, GC), (2.0 * GC) ** -0.5),
        "ssm_b_im": nrm(ks[21], (L, 2, G, P, GC), (2.0 * GC) ** -0.5),
        "ssm_c_re": nrm(ks[22], (L, 2, G, GC, P), (2.0 * P) ** -0.5),
        "ssm_c_im": nrm(ks[23], (L, 2, G, GC, P), (2.0 * P) ** -0.5),
        "ssm_d": nrm(ks[24], (L, SSM_DIM), 1.0),
        "ssm_w_glu": nrm(ks[25], (L, SSM_DIM, 2 * D_MODEL), SSM_DIM ** -0.5),
        "ssm_b_glu": nrm(ks[26], (L, 2 * D_MODEL), 0.01),
        "w_out": nrm(ks[27], (L, D_MODEL, D_MODEL), D_MODEL ** -0.5),
        "norm_ffn2": gain(ks[28], (L, D_MODEL)),
        "ffn2_w_up": nrm(ks[29], (L, D_MODEL, 2 * D_FF), D_MODEL ** -0.5),
        "ffn2_w_down": nrm(ks[30], (L, D_FF, D_MODEL), D_FF ** -0.5),
        "norm_final": gain(ks[31], (D_MODEL,)),
    }


def reference(x, c, ctx, c_ctx, ada_w, ada_b, norm_ffn1, ffn1_w_up, ffn1_w_down,
              norm_mix, w_in, b_in, conv_dw, conv_db, conv_ln_g, conv_ln_b, conv_w_out,
              ssm_a_re, ssm_a_im, ssm_log_dt, ssm_b_re, ssm_b_im, ssm_c_re, ssm_c_im,
              ssm_d, ssm_w_glu, ssm_b_glu, w_out, norm_ffn2, ffn2_w_up, ffn2_w_down,
              norm_final):
    rows = x.shape[1] // GRID_W
    xc = ctx
    for i in range(DEPTH):
        p = dict(
            ada_w=ada_w[i], ada_b=ada_b[i],
            norm_ffn1=norm_ffn1[i], ffn1_w_up=ffn1_w_up[i], ffn1_w_down=ffn1_w_down[i],
            norm_mix=norm_mix[i], w_in=w_in[i], b_in=b_in[i],
            conv_dw=conv_dw[i], conv_db=conv_db[i], conv_ln_g=conv_ln_g[i],
            conv_ln_b=conv_ln_b[i], conv_w_out=conv_w_out[i],
            ssm_a_re=ssm_a_re[i], ssm_a_im=ssm_a_im[i], ssm_log_dt=ssm_log_dt[i],
            ssm_b_re=ssm_b_re[i], ssm_b_im=ssm_b_im[i], ssm_c_re=ssm_c_re[i], ssm_c_im=ssm_c_im[i],
            ssm_d=ssm_d[i], ssm_w_glu=ssm_w_glu[i], ssm_b_glu=ssm_b_glu[i],
            w_out=w_out[i],
            norm_ffn2=norm_ffn2[i], ffn2_w_up=ffn2_w_up[i], ffn2_w_down=ffn2_w_down[i],
        )
        x, xc = layer(x, xc, c, c_ctx, p, rows, i < DEPTH - 1)
    return rmsnorm(x, norm_final)
```

```cpp
#include <hip/hip_runtime.h>
#include <cstdio>
#include <cstdint>
namespace pg8 {
#define PG8_LAS __attribute__((address_space(3)))
typedef unsigned short bf16_t;
typedef short bf16x8 __attribute__((ext_vector_type(8)));
typedef float f32x4 __attribute__((ext_vector_type(4)));
typedef unsigned u32x4 __attribute__((ext_vector_type(4)));
constexpr int BM = 256, BK = 64, HALF = 128, HTB = HALF * BK * 2  , STAGE_BYTES = 8 * HTB, NXCD = 8, WGM = 8;

__host__ __device__ __forceinline__ int lds_byte(int r, int c) { const int st = (r >> 4) * 2 + (c >> 5), rr = r & 15, cc = c & 31, ob = rr * 64 + cc * 2; return st * 1024 + (ob ^ (((ob >> 9) & 1) << 5)); }
__host__ __device__ __forceinline__ void stage_rc(int b, int& R, int& C) { const int st = b / 1024, sb = b % 1024, swz = sb ^ (((sb >> 9) & 1) << 5); R = (st >> 1) * 16 + swz / 64; C = (st & 1) * 32 + (swz % 64) / 2; }
__host__ __device__ __forceinline__ int perm32(int rho) { const int n = rho >> 4, i = rho & 15; return 8 * (i >> 2) + 4 * n + (i & 3); }

struct Unit { int pm, pn; };
struct Gemm { const bf16_t* A; const bf16_t* Bt; int M, N, K; };

struct StaticOrder {
    int nM, nN, nwg, G, c;
    __host__ __device__ void init(int M, int N, int G_, int c_) { nM = M / BM; nN = N / BM; nwg = nM * nN; G = G_; c = c_; }
    __host__ __device__ bool next(int i, Unit& u) const {
        const long L = (long)i * G + c; if (L >= nwg) return false;
        int wgid = (int)L; { const int q = nwg / NXCD, r = nwg % NXCD, xcd = wgid % NXCD, off = wgid / NXCD; wgid = (xcd < r ? xcd * (q + 1) : r * (q + 1) + (xcd - r) * q) + off; }
        const int nig = WGM * nN, gid = wgid / nig, fm = gid * WGM, gsz = (nM - fm) < WGM ? (nM - fm) : WGM;
        u.pm = fm + ((wgid % nig) % gsz); u.pn = (wgid % nig) / gsz; return true;
    }
    __device__ __forceinline__ void a_ready(const Unit&) const {}
    __device__ __forceinline__ void done(const Unit&) const {}
};
__device__ __forceinline__ unsigned cvt_pk_bf16(float lo, float hi) { unsigned r; asm volatile("v_cvt_pk_bf16_f32 %0, %1, %2" : "=v"(r) : "v"(lo), "v"(hi)); return r; }
struct Order {
    int nM, nN, nwg, G, c, ex_n, ex_pm0, ex_pn0, ex_w;
    __device__ void init(int M, int N, int G_, int c_) { nM = M / BM; nN = N / BM; nwg = nM * nN; G = G_; c = c_; ex_n = 0; ex_pm0 = 0; ex_pn0 = 0; ex_w = 1; }
    __device__ void extra(int n, int pm0, int pn0, int w) { ex_n = n; ex_pm0 = pm0; ex_pn0 = pn0; ex_w = w; }
    __device__ bool next(int i, Unit& u) const {
        const long L = (long)i * G + c;
        if (L >= nwg) { const int e = (int)(L - nwg); if (e >= ex_n) return false; u.pm = ex_pm0 + e / ex_w; u.pn = ex_pn0 + e % ex_w; return true; }
        int wgid = (int)L; { const int q = nwg / NXCD, r = nwg % NXCD, xcd = wgid % NXCD, off = wgid / NXCD; wgid = (xcd < r ? xcd * (q + 1) : r * (q + 1) + (xcd - r) * q) + off; }
        const int nig = WGM * nN, gid = wgid / nig, fm = gid * WGM, gsz = (nM - fm) < WGM ? (nM - fm) : WGM;
        u.pm = fm + ((wgid % nig) % gsz); u.pn = (wgid % nig) / gsz; return true;
    }
    __device__ __forceinline__ void a_ready(const Unit&) const {}
    __device__ __forceinline__ void done(const Unit&) const {}
};

__device__ __forceinline__ float fsigmoid(float x) { return __builtin_amdgcn_rcpf(1.0f + __expf(-x)); }
__device__ __forceinline__ float fsilu(float x) { return x * fsigmoid(x); }
__device__ __forceinline__ f32x4 bf4_lo(u32x4 w, int half) {
    const unsigned a = half ? w.z : w.x, b = half ? w.w : w.y;
    return (f32x4){__uint_as_float(a << 16), __uint_as_float(a & 0xffff0000u), __uint_as_float(b << 16), __uint_as_float(b & 0xffff0000u)};
}

struct EpiSwiGLU {
    static constexpr bool PERM = true, AFTER_DRAIN = false;
    bf16_t* O; int ldc;
    __device__ __forceinline__ void operator()(const f32x4 (&acc)[2][2][4][2], const Unit& u, int wr, int wc, int fr, int fq) const {
        const int row0 = u.pm * BM + wr * 64 + fr, col0 = u.pn * HALF + wc * 32 + 8 * fq;
#pragma unroll
        for (int ai = 0; ai < 2; ++ai)
#pragma unroll
            for (int m = 0; m < 4; ++m) {
                bf16_t* rowp = O + (size_t)(row0 + ai * HALF + m * 16) * ldc + col0;
                float r[8];
#pragma unroll
                for (int n = 0; n < 2; ++n)
#pragma unroll
                    for (int j = 0; j < 4; ++j) r[4 * n + j] = fsilu(acc[ai][1][m][n][j]) * acc[ai][0][m][n][j];
                u32x4 w; w.x = cvt_pk_bf16(r[0], r[1]); w.y = cvt_pk_bf16(r[2], r[3]); w.z = cvt_pk_bf16(r[4], r[5]); w.w = cvt_pk_bf16(r[6], r[7]);
                *(u32x4*)rowp = w;
            }
    }
};

struct EpiResid {
    static constexpr bool PERM = false, AFTER_DRAIN = false;
    const float* base_lat; const float* base_ctx; float* out; const float* gate; float scale;
    __device__ __forceinline__ void operator()(const f32x4 (&acc)[2][2][4][2], const Unit& u, int wr, int wc, int fr, int fq) const {
        const int row0 = u.pm * BM + wr * 64 + fr, col0 = u.pn * BM + wc * 32 + 4 * fq;
        const int mrow = u.pm < 32 ? (u.pm >> 3) : 4;
        f32x4 gv[2][2];
#pragma unroll
        for (int bj = 0; bj < 2; ++bj)
#pragma unroll
            for (int n = 0; n < 2; ++n) gv[bj][n] = *(const f32x4*)(gate + (size_t)mrow * 18432 + col0 + bj * HALF + n * 16) * scale;
#pragma unroll
        for (int ai = 0; ai < 2; ++ai)
#pragma unroll
            for (int m = 0; m < 4; ++m) {
                const int r = row0 + ai * HALF + m * 16;
                const float* bp = (r < 8192 ? base_lat + (size_t)r * 2048 : base_ctx + (size_t)(r - 8192) * 2048) + col0;
                float* op = out + (size_t)r * 2048 + col0;
#pragma unroll
                for (int bj = 0; bj < 2; ++bj)
#pragma unroll
                    for (int n = 0; n < 2; ++n) *(f32x4*)(op + bj * HALF + n * 16) = *(const f32x4*)(bp + bj * HALF + n * 16) + gv[bj][n] * acc[ai][bj][m][n];
            }
    }
};

struct EpiProj {
    static constexpr bool PERM = true, AFTER_DRAIN = false;
    bf16_t* UCONV; bf16_t* SSMIN; bf16_t* GATES; const float* bias;
    __device__ __forceinline__ void operator()(const f32x4 (&acc)[2][2][4][2], const Unit& u, int wr, int wc, int fr, int fq) const {
        const int row0 = u.pm * BM + wr * 64 + fr, jj = wc * 32 + 8 * fq;
        if (u.pn < 8) {
            const int col0 = u.pn * HALF + jj;
            f32x4 ba[2], bg[2];
#pragma unroll
            for (int n = 0; n < 2; ++n) { ba[n] = *(const f32x4*)(bias + col0 + 4 * n); bg[n] = *(const f32x4*)(bias + 1024 + col0 + 4 * n); }
#pragma unroll
            for (int ai = 0; ai < 2; ++ai)
#pragma unroll
                for (int m = 0; m < 4; ++m) {
                    bf16_t* rowp = UCONV + (size_t)(row0 + ai * HALF + m * 16) * 1024 + col0;
                    float r[8];
#pragma unroll
                    for (int n = 0; n < 2; ++n)
#pragma unroll
                        for (int j = 0; j < 4; ++j) r[4 * n + j] = (acc[ai][0][m][n][j] + ba[n][j]) * fsigmoid(acc[ai][1][m][n][j] + bg[n][j]);
                    u32x4 w; w.x = cvt_pk_bf16(r[0], r[1]); w.y = cvt_pk_bf16(r[2], r[3]); w.z = cvt_pk_bf16(r[4], r[5]); w.w = cvt_pk_bf16(r[6], r[7]);
                    *(u32x4*)rowp = w;
                }
        } else {
            const bool is_gate = u.pn >= 12;
            bf16_t* O = is_gate ? GATES : SSMIN; const int ldc = is_gate ? 4096 : 1024;
            const int col0 = (is_gate ? (u.pn - 12) : (u.pn - 8)) * BM + jj, bcol0 = u.pn * BM + jj;
            f32x4 bv[2][2];
#pragma unroll
            for (int bj = 0; bj < 2; ++bj)
#pragma unroll
                for (int n = 0; n < 2; ++n) bv[bj][n] = *(const f32x4*)(bias + bcol0 + bj * HALF + 4 * n);
#pragma unroll
            for (int ai = 0; ai < 2; ++ai)
#pragma unroll
                for (int m = 0; m < 4; ++m) {
                    bf16_t* rowp = O + (size_t)(row0 + ai * HALF + m * 16) * ldc + col0;
#pragma unroll
                    for (int bj = 0; bj < 2; ++bj) {
                        f32x4 v0 = acc[ai][bj][m][0] + bv[bj][0], v1 = acc[ai][bj][m][1] + bv[bj][1];
                        if (is_gate) {
#pragma unroll
                            for (int j = 0; j < 4; ++j) { v0[j] = fsigmoid(v0[j]); v1[j] = fsigmoid(v1[j]); }
                        }
                        u32x4 w; w.x = cvt_pk_bf16(v0[0], v0[1]); w.y = cvt_pk_bf16(v0[2], v0[3]); w.z = cvt_pk_bf16(v1[0], v1[1]); w.w = cvt_pk_bf16(v1[2], v1[3]);
                        *(u32x4*)(rowp + bj * HALF) = w;
                    }
                }
        }
    }
};

struct EpiGluGate {
    static constexpr bool PERM = true, AFTER_DRAIN = false;
    bf16_t* T1; const bf16_t* GATES; const float* bias;
    __device__ __forceinline__ void operator()(const f32x4 (&acc)[2][2][4][2], const Unit& u, int wr, int wc, int fr, int fq) const {
        const int row0 = u.pm * BM + wr * 64 + fr, col0 = u.pn * HALF + wc * 32 + 8 * fq;
        f32x4 ba[2], bg[2];
#pragma unroll
        for (int n = 0; n < 2; ++n) { ba[n] = *(const f32x4*)(bias + col0 + 4 * n); bg[n] = *(const f32x4*)(bias + 2048 + col0 + 4 * n); }
#pragma unroll
        for (int ai = 0; ai < 2; ++ai)
#pragma unroll
            for (int m = 0; m < 4; ++m) {
                const size_t r = (size_t)(row0 + ai * HALF + m * 16);
                const u32x4 gw = *(const u32x4*)(GATES + r * 4096 + 2048 + col0);
                float rr[8];
#pragma unroll
                for (int n = 0; n < 2; ++n) { const f32x4 gs = bf4_lo(gw, n);
#pragma unroll
                    for (int j = 0; j < 4; ++j) rr[4 * n + j] = gs[j] * (acc[ai][0][m][n][j] + ba[n][j]) * fsigmoid(acc[ai][1][m][n][j] + bg[n][j]); }
                u32x4 w; w.x = cvt_pk_bf16(rr[0], rr[1]); w.y = cvt_pk_bf16(rr[2], rr[3]); w.z = cvt_pk_bf16(rr[4], rr[5]); w.w = cvt_pk_bf16(rr[6], rr[7]);
                *(u32x4*)(T1 + r * 2048 + col0) = w;
            }
    }
};

struct EpiConvMix {
    static constexpr bool PERM = true, AFTER_DRAIN = false;
    bf16_t* MIX; const bf16_t* GATES; const bf16_t* T1;
    __device__ __forceinline__ void operator()(const f32x4 (&acc)[2][2][4][2], const Unit& u, int wr, int wc, int fr, int fq) const {
        const int row0 = u.pm * BM + wr * 64 + fr, col0 = u.pn * BM + wc * 32 + 8 * fq;
#pragma unroll
        for (int ai = 0; ai < 2; ++ai)
#pragma unroll
            for (int m = 0; m < 4; ++m) {
                const size_t r = (size_t)(row0 + ai * HALF + m * 16);
#pragma unroll
                for (int bj = 0; bj < 2; ++bj) {
                    const u32x4 gw = *(const u32x4*)(GATES + r * 4096 + col0 + bj * HALF);
                    const u32x4 tw = *(const u32x4*)(T1 + r * 2048 + col0 + bj * HALF);
                    const f32x4 v0 = bf4_lo(gw, 0) * acc[ai][bj][m][0] + bf4_lo(tw, 0), v1 = bf4_lo(gw, 1) * acc[ai][bj][m][1] + bf4_lo(tw, 1);
                    u32x4 w; w.x = cvt_pk_bf16(v0[0], v0[1]); w.y = cvt_pk_bf16(v0[2], v0[3]); w.z = cvt_pk_bf16(v1[0], v1[1]); w.w = cvt_pk_bf16(v1[2], v1[3]);
                    *(u32x4*)(MIX + r * 2048 + col0 + bj * HALF) = w;
                }
            }
    }
};

template <class Epi, class Sched, bool ALIGN_EPI = false, bool SP2 = false>
__device__ __forceinline__ void gemm_phase(PG8_LAS unsigned char* lds, const Gemm g, const Sched& S, const Epi& E) {
    int tid_ = threadIdx.x; asm volatile("" : "+v"(tid_));
    const int tid = tid_, wid = __builtin_amdgcn_readfirstlane(tid >> 6), lane = tid & 63, wr = wid >> 2, wc = wid & 3, fr = lane & 15, fq = lane >> 4;
    const int K = g.K, nt = K / BK;
    unsigned voffA[2], voffB[2];
#pragma unroll
    for (int i = 0; i < 2; ++i) { int R, C; stage_rc(tid * 16 + i * 8192, R, C); const int Rb = Epi::PERM ? ((R & ~31) + perm32(R & 31)) : R;
        voffA[i] = (unsigned)(R * K + C) * 2u; voffB[i] = (unsigned)(Rb * K + C) * 2u; }
    const size_t kstep = (size_t)(BK * 2);
    const size_t hstep = (size_t)HALF * K * 2;
    const size_t tstep = 2 * hstep;
    const unsigned ldsw = (unsigned)wid * 1024u;
    const int aoff = lds_byte(wr * 64 + fr, fq * 8), boff = lds_byte(wc * 32 + fr, fq * 8);
#define PG8_SA(b, h) (((b) * 2 + (h)) * HTB)
#define PG8_SB(b, h) ((4 + (b) * 2 + (h)) * HTB)
#define PG8_STAGE(bufoff, gbase, voff) do { _Pragma("unroll") for (int _i = 0; _i < 2; ++_i) \
        __builtin_amdgcn_global_load_lds((const unsigned*)((const char*)(gbase) + (voff)[_i]), (PG8_LAS unsigned*)(lds + (bufoff) + ldsw + _i * 8192), 16, 0, 0); } while (0)
#define PG8_LDA(dst, b, h) do { _Pragma("unroll") for (int m = 0; m < 4; ++m) _Pragma("unroll") for (int k = 0; k < 2; ++k) dst[m][k] = *(const PG8_LAS bf16x8*)(lds + PG8_SA(b, h) + aoff + m * 2048 + k * 1024); } while (0)
#define PG8_LDB(dst, b, h) do { _Pragma("unroll") for (int n = 0; n < 2; ++n) _Pragma("unroll") for (int k = 0; k < 2; ++k) dst[n][k] = *(const PG8_LAS bf16x8*)(lds + PG8_SB(b, h) + boff + n * 2048 + k * 1024); } while (0)
#define PG8_MMA(ai, bj, At, Bt) do { __builtin_amdgcn_s_setprio(1); _Pragma("unroll") for (int m = 0; m < 4; ++m) _Pragma("unroll") for (int n = 0; n < 2; ++n) _Pragma("unroll") for (int k = 0; k < 2; ++k) \
        acc[ai][bj][m][n] = __builtin_amdgcn_mfma_f32_16x16x32_bf16(Bt[n][k], At[m][k], acc[ai][bj][m][n], 0, 0, 0); __builtin_amdgcn_s_setprio(0); } while (0)
#define PG8_WAIT_V(n) asm volatile("s_waitcnt vmcnt(" #n ")" ::: "memory")
#define PG8_WAIT_L(n) asm volatile("s_waitcnt lgkmcnt(" #n ")" ::: "memory")
#define PG8_BAR __builtin_amdgcn_s_barrier()
#define PG8_SCHED __builtin_amdgcn_sched_barrier(0)
    Unit cur, nxt; int ui = 0;
    if (!S.next(0, cur)) return;
    f32x4 acc[2][2][4][2];
#pragma unroll
    for (int a = 0; a < 2; ++a)
#pragma unroll
        for (int b = 0; b < 2; ++b)
#pragma unroll
            for (int m = 0; m < 4; ++m)
#pragma unroll
                for (int n = 0; n < 2; ++n) acc[a][b][m][n] = (f32x4){0.f, 0.f, 0.f, 0.f};
    bf16x8 At[4][2], B0[2][2], B1[2][2];
    const char* cA = (const char*)g.A + (size_t)cur.pm * tstep; const char* cB = (const char*)g.Bt + (size_t)cur.pn * tstep;
    S.a_ready(cur);
    if constexpr (SP2) {
        PG8_STAGE(PG8_SB(0, 0), cB, voffB); PG8_STAGE(PG8_SB(0, 1), cB + hstep, voffB); PG8_STAGE(PG8_SA(0, 0), cA, voffA); PG8_STAGE(PG8_SA(0, 1), cA + hstep, voffA);
        if (wr == 1) PG8_BAR;
        PG8_WAIT_V(2); PG8_BAR;
        PG8_STAGE(PG8_SB(1, 0), cB + kstep, voffB); PG8_STAGE(PG8_SA(1, 0), cA + kstep, voffA); PG8_STAGE(PG8_SB(1, 1), cB + hstep + kstep, voffB);
        PG8_WAIT_V(6); PG8_BAR;
    } else {
        PG8_STAGE(PG8_SB(0, 0), cB, voffB); PG8_STAGE(PG8_SA(0, 0), cA, voffA); PG8_STAGE(PG8_SB(0, 1), cB + hstep, voffB); PG8_STAGE(PG8_SA(0, 1), cA + hstep, voffA);
        if (wr == 1) PG8_BAR;
        PG8_WAIT_V(4); PG8_BAR;
        PG8_STAGE(PG8_SB(1, 0), cB + kstep, voffB); PG8_STAGE(PG8_SA(1, 0), cA + kstep, voffA); PG8_STAGE(PG8_SB(1, 1), cB + hstep + kstep, voffB);
        PG8_WAIT_V(6); PG8_BAR;
    }
    for (;;) {
        const bool has_next = S.next(ui + 1, nxt);
        const char* nA = has_next ? (const char*)g.A + (size_t)nxt.pm * tstep : cA; const char* nB = has_next ? (const char*)g.Bt + (size_t)nxt.pn * tstep : cB;
        for (int t = 0; t < nt; t += 2) {
            const bool last = (t == nt - 2);
            const char* a1 = cA + (size_t)(t + 1) * kstep;
            const char* a2 = last ? nA : cA + (size_t)(t + 2) * kstep; const char* b2 = last ? nB : cB + (size_t)(t + 2) * kstep;
            const char* a3 = a2 + kstep; const char* b3 = b2 + kstep;
            if (last && has_next) S.a_ready(nxt);
            if constexpr (SP2) {
            PG8_LDB(B0, 0, 0); PG8_LDB(B1, 0, 1); PG8_SCHED; PG8_LDA(At, 0, 0); PG8_STAGE(PG8_SA(1, 1), a1 + hstep, voffA);
            PG8_WAIT_V(8); PG8_WAIT_L(0); PG8_BAR; PG8_MMA(0, 0, At, B0); PG8_MMA(0, 1, At, B1); PG8_BAR; PG8_SCHED;
            PG8_LDA(At, 0, 1); PG8_STAGE(PG8_SB(0, 0), b2, voffB); PG8_STAGE(PG8_SB(0, 1), b2 + hstep, voffB); PG8_STAGE(PG8_SA(0, 0), a2, voffA);
            PG8_WAIT_V(8); PG8_WAIT_L(0); PG8_BAR; PG8_MMA(1, 0, At, B0); PG8_MMA(1, 1, At, B1); PG8_BAR; PG8_SCHED;
            PG8_LDB(B0, 1, 0); PG8_LDB(B1, 1, 1); PG8_SCHED; PG8_LDA(At, 1, 0); PG8_STAGE(PG8_SA(0, 1), a2 + hstep, voffA);
            PG8_WAIT_V(8); PG8_WAIT_L(0); PG8_BAR; PG8_MMA(0, 0, At, B0); PG8_MMA(0, 1, At, B1); PG8_BAR; PG8_SCHED;
            PG8_LDA(At, 1, 1); PG8_STAGE(PG8_SB(1, 0), b3, voffB); PG8_STAGE(PG8_SB(1, 1), b3 + hstep, voffB); PG8_STAGE(PG8_SA(1, 0), a3, voffA);
            PG8_WAIT_V(8); PG8_WAIT_L(0); PG8_BAR; PG8_MMA(1, 0, At, B0); PG8_MMA(1, 1, At, B1); PG8_BAR; PG8_SCHED;
            } else {
            PG8_LDB(B0, 0, 0); PG8_SCHED; PG8_LDA(At, 0, 0); PG8_STAGE(PG8_SA(1, 1), a1 + hstep, voffA);
            PG8_WAIT_L(8); PG8_BAR; PG8_WAIT_L(0); PG8_MMA(0, 0, At, B0); PG8_BAR; PG8_SCHED;
            PG8_LDB(B1, 0, 1); PG8_STAGE(PG8_SB(0, 0), b2, voffB);
            PG8_BAR; PG8_WAIT_L(0); PG8_MMA(0, 1, At, B1); PG8_BAR;
            PG8_LDA(At, 0, 1); PG8_STAGE(PG8_SA(0, 0), a2, voffA);
            PG8_BAR; PG8_WAIT_L(0); PG8_MMA(1, 0, At, B0); PG8_BAR; PG8_SCHED;
            PG8_STAGE(PG8_SB(0, 1), b2 + hstep, voffB);
            PG8_WAIT_V(6); PG8_BAR; PG8_MMA(1, 1, At, B1); PG8_BAR;
            PG8_LDB(B0, 1, 0); PG8_SCHED; PG8_LDA(At, 1, 0); PG8_STAGE(PG8_SA(0, 1), a2 + hstep, voffA);
            PG8_WAIT_L(8); PG8_BAR; PG8_WAIT_L(0); PG8_MMA(0, 0, At, B0); PG8_BAR; PG8_SCHED;
            PG8_LDB(B1, 1, 1); PG8_STAGE(PG8_SB(1, 0), b3, voffB);
            PG8_BAR; PG8_WAIT_L(0); PG8_MMA(0, 1, At, B1); PG8_BAR;
            PG8_LDA(At, 1, 1); PG8_STAGE(PG8_SA(1, 0), a3, voffA);
            PG8_BAR; PG8_WAIT_L(0); PG8_MMA(1, 0, At, B0); PG8_BAR; PG8_SCHED;
            PG8_STAGE(PG8_SB(1, 1), b3 + hstep, voffB);
            PG8_WAIT_V(6); PG8_BAR; PG8_MMA(1, 1, At, B1); PG8_BAR;
            }
        }
        if constexpr (ALIGN_EPI) { if (wr == 0) PG8_BAR; }
        if constexpr (!Epi::AFTER_DRAIN) { E(acc, cur, wr, wc, fr, fq); S.done(cur); }
        if (!has_next) break;
#pragma unroll
        for (int a = 0; a < 2; ++a)
#pragma unroll
            for (int b = 0; b < 2; ++b)
#pragma unroll
                for (int m = 0; m < 4; ++m)
#pragma unroll
                    for (int n = 0; n < 2; ++n) acc[a][b][m][n] = (f32x4){0.f, 0.f, 0.f, 0.f};
        cur = nxt; cA = nA; cB = nB; ++ui;
        if constexpr (ALIGN_EPI) { if (wr == 1) PG8_BAR; }
    }
    PG8_WAIT_V(0);
    if constexpr (!ALIGN_EPI) { if (wr == 0) PG8_BAR; }
    PG8_BAR;
    if constexpr (Epi::AFTER_DRAIN) { E.fused(acc, cur, wr, wc, fr, fq, lds, wid, lane); S.done(cur); }
#undef PG8_SA
#undef PG8_SB
#undef PG8_STAGE
#undef PG8_LDA
#undef PG8_LDB
#undef PG8_MMA
#undef PG8_WAIT_V
#undef PG8_WAIT_L
#undef PG8_BAR
#undef PG8_SCHED
}
}
#define GAS __attribute__((address_space(1)))
#define LAS __attribute__((address_space(3)))
typedef unsigned short bf16;
typedef unsigned v4u __attribute__((ext_vector_type(4)));
typedef float f32x4 __attribute__((ext_vector_type(4)));
typedef short bf16x8 __attribute__((ext_vector_type(8)));
typedef GAS unsigned gu32;
typedef GAS unsigned long long gu64;
#define RLX_AGENT __ATOMIC_RELAXED, __HIP_MEMORY_SCOPE_AGENT
#define LDS_WAIT() asm volatile("s_waitcnt lgkmcnt(0)" ::: "memory")
#define VM_WAIT() asm volatile("s_waitcnt vmcnt(0)" ::: "memory")
__device__ __forceinline__ unsigned long long rt() { return __builtin_amdgcn_s_memrealtime(); }
__device__ __forceinline__ unsigned f2bf(float f) { unsigned u = __builtin_bit_cast(unsigned, f); return (u + 0x7fffu + ((u >> 16) & 1u)) >> 16; }
__device__ __forceinline__ unsigned pk2(float lo, float hi) { return f2bf(lo) | (f2bf(hi) << 16); }
#define XB_TMO      128
#define XB_XCNT(j)  (256  + 64 * (j))
#define XB_XSUB(j)  (1280 + 64 * (j))
#define XB_XGEN(j)  (2304 + 64 * (j))
#define XB_TOP      3328
#define XB_TOPGEN   3392
#define XCD_BAR_WORDS 3456
#define XB_SPIN_CAP (1u << 18)

__device__ __forceinline__ unsigned xb_ld(unsigned* p)              { return __hip_atomic_load(p, __ATOMIC_RELAXED, __HIP_MEMORY_SCOPE_AGENT); }
__device__ __forceinline__ unsigned xb_add(unsigned* p, unsigned v) { return __hip_atomic_fetch_add(p, v, __ATOMIC_RELAXED, __HIP_MEMORY_SCOPE_AGENT); }
__device__ __forceinline__ unsigned xb_xcc_id() { return (unsigned)__builtin_amdgcn_s_getreg((3 << 11) | 20) & 0xFu; }
#define XB_SPIN(cond, bar) do { unsigned _sp = 0; while (cond) { __builtin_amdgcn_s_sleep(1); \
    if ((++_sp & 255u) == 0u) { if (xb_ld(&(bar)[XB_TMO])) break; if (_sp > XB_SPIN_CAP) { atomicAdd(&(bar)[XB_TMO], 1u); break; } } } } while (0)

struct XcdBarrier {
    unsigned* bar; unsigned x;
    volatile LAS unsigned* st;
};

__device__ __forceinline__ XcdBarrier xcd_barrier_post(unsigned* bar, volatile LAS unsigned* st) {
    XcdBarrier b; b.bar = bar; b.x = xb_xcc_id(); b.st = st;
    if (threadIdx.x == 0) (void)xb_add(&bar[XB_XCNT(b.x)], 1u);
    return b;
}
__device__ __forceinline__ void xcd_barrier_complete(unsigned* bar, unsigned x, unsigned& nloc, unsigned& nx) {
    const unsigned G = gridDim.x * gridDim.y * gridDim.z;
    unsigned sum, cnt, mine, sp = 0u;
    for (;;) {
        sum = 0u; cnt = 0u; mine = 0u;
#pragma unroll
        for (unsigned j = 0; j < 16; ++j) { const unsigned c = xb_ld(&bar[XB_XCNT(j)]); sum += c; cnt += (c > 0u) ? 1u : 0u; mine = (j == x) ? c : mine; }
        if (sum == G) break;
        __builtin_amdgcn_s_sleep(1);
        if ((++sp & 255u) == 0u) { if (xb_ld(&bar[XB_TMO])) break; if (sp > XB_SPIN_CAP) { atomicAdd(&bar[XB_TMO], 1u); break; } }
    }
    nloc = mine > 0u ? mine : 1u; nx = cnt > 0u ? cnt : 1u;
}

__device__ __forceinline__ void xcd_barrier(const XcdBarrier& b) {
    asm volatile("s_waitcnt vmcnt(0)" ::: "memory");
    __syncthreads();
    if (threadIdx.x == 0) {
        unsigned* bar = b.bar;
        __builtin_amdgcn_s_waitcnt(0);
        unsigned nloc = b.st[0], nx = b.st[1];
        if (nloc == 0u) { xcd_barrier_complete(bar, b.x, nloc, nx); b.st[0] = nloc; b.st[1] = nx; }
        const unsigned old = xb_add(&bar[XB_XSUB(b.x)], 1u);
        const unsigned gen = old / nloc;
        if (old + 1u == (gen + 1u) * nloc) {
            __builtin_amdgcn_fence(__ATOMIC_RELEASE, "agent");
            asm volatile("s_waitcnt vmcnt(0)" ::: "memory");
            const unsigned og = xb_add(&bar[XB_TOP], 1u);
            const unsigned tg = og / nx;
            if (og + 1u == (tg + 1u) * nx) xb_add(&bar[XB_TOPGEN], 1u);
            else XB_SPIN(xb_ld(&bar[XB_TOPGEN]) == tg, bar);
            __builtin_amdgcn_fence(__ATOMIC_ACQUIRE, "agent");
            xb_add(&bar[XB_XGEN(b.x)], 1u);
            asm volatile("s_waitcnt vmcnt(0)" ::: "memory");
        } else {
            XB_SPIN(xb_ld(&bar[XB_XGEN(b.x)]) == gen, bar);
            __builtin_amdgcn_fence(__ATOMIC_ACQUIRE, "agent");
            asm volatile("s_waitcnt vmcnt(0)" ::: "memory");
        }
    }
    __syncthreads();
}
constexpr int NWAVES = 8;
constexpr int DM = 2048, NBATCH = 4, SEQ = 2048, CTXL = 256, DFF = 5632, CDIM = 1024, CONVK = 31, SDIM = 1024, NGRP = 64, NST = 64, NIN = 7168, MODW = 9 * DM;
constexpr int ML = NBATCH * SEQ, MC = NBATCH * CTXL, MT = ML + MC;
constexpr float EPS = 1e-6f;
#ifndef MK_PER_PHASE
#define MK_PER_PHASE 1
#endif

constexpr size_t MiB = 1u << 20;
constexpr size_t WS_CTL = 0, WS_MOD = 1 * MiB, ZERO_BYTES = 2 * MiB;
constexpr size_t WS_LAM = 2 * MiB, WS_LAMT = WS_LAM + 128 * 1024, WS_BOP = 3 * MiB, WS_COP = 4 * MiB;
constexpr size_t WS_W = 6 * MiB, W_LAYER = 180 * MiB;
constexpr size_t WO_UP1 = 0, WO_DN1 = 44 * MiB, WO_IN = 66 * MiB, WO_CO = 94 * MiB, WO_GLU = 98 * MiB, WO_OUT = 106 * MiB, WO_UP2 = 114 * MiB, WO_DN2 = 158 * MiB;
constexpr size_t WS_X = 366 * MiB, WS_H = 438 * MiB, WS_ACT = 474 * MiB, WS_UCONV = 573 * MiB, WS_SSMIN = 591 * MiB, WS_GATES = 609 * MiB, WS_CONVACT = 681 * MiB, WS_SSMACT = 699 * MiB;
constexpr size_t WS_YF = 717 * MiB, WS_YB = 753 * MiB, WS_T1 = 789 * MiB, WS_MIX = 825 * MiB, WS_E = 861 * MiB, WS_END = 864 * MiB;
constexpr int CW_TMO = 0, CW_BAR = 4096;
constexpr int RING_OFF = 0, RING_BYTES = 131072, LDSCTL_OFF = RING_BYTES, MISC_OFF = LDSCTL_OFF + 320, LDS_BYTES = 147456;

typedef float f32x2 __attribute__((ext_vector_type(2)));
typedef float f32x16 __attribute__((ext_vector_type(16)));
typedef unsigned u32x2 __attribute__((ext_vector_type(2)));
__device__ __forceinline__ float wave_sum(float v) {
#pragma unroll
    for (int o = 1; o < 64; o <<= 1) v += __shfl_xor(v, o);
    return v;
}
__device__ __forceinline__ unsigned pkbf(float lo, float hi) { return pg8::cvt_pk_bf16(lo, hi); }
__device__ __forceinline__ float bf_lo(unsigned w) { return __uint_as_float(w << 16); }
__device__ __forceinline__ float bf_hi(unsigned w) { return __uint_as_float(w & 0xffff0000u); }
__device__ __forceinline__ float gelu_tanh(float x) {
    const float z = 0.7978845608028654f * (x + 0.044715f * x * x * x);
    const float e = __expf(2.0f * z);
    const float t = 1.0f - 2.0f * __builtin_amdgcn_rcpf(e + 1.0f);
    return 0.5f * x * (1.0f + t);
}
__device__ __forceinline__ float sigm(float x) { return __builtin_amdgcn_rcpf(1.0f + __expf(-x)); }

struct Args { const float* in[32]; float* out; unsigned char* ws; int ph_lo, ph_hi; };

struct Frame {
    LAS unsigned char* lds;
    int tid, lane, wave, vcu, G;
    unsigned char* ws;
};

__device__ __forceinline__ Frame refresh(const Frame& F0) { Frame F = F0; int t = threadIdx.x; asm volatile("" : "+v"(t)); F.tid = t; F.lane = t & 63; F.wave = __builtin_amdgcn_readfirstlane(t >> 6); return F; }
__device__ __forceinline__ void transpose_item(const float* W, int K, int N, bf16* WT, int k0, int n0, int drow0, LAS float* scr, int lane) {
#pragma unroll 8
    for (int i = 0; i < 32; ++i) { const int kk = 2 * i + (lane >> 5); scr[kk * 33 + (lane & 31)] = W[(size_t)(k0 + kk) * N + n0 + (lane & 31)]; }
    LDS_WAIT(); asm volatile("" ::: "memory");
    const int c = lane & 7;
#pragma unroll
    for (int j = 0; j < 4; ++j) { const int n = (lane >> 3) + 8 * j; const LAS float* s = scr + (8 * c) * 33 + n;
        v4u o; o.x = pkbf(s[0 * 33], s[1 * 33]); o.y = pkbf(s[2 * 33], s[3 * 33]); o.z = pkbf(s[4 * 33], s[5 * 33]); o.w = pkbf(s[6 * 33], s[7 * 33]);
        *(GAS v4u*)(WT + (size_t)(drow0 + n) * K + k0 + 8 * c) = o; }
    LDS_WAIT(); asm volatile("" ::: "memory");
}
__device__ __forceinline__ int glu_row(int n, int HC) { const int half = n >= HC ? 1 : 0, j = n - half * HC; return (j >> 7) * 256 + half * 128 + (j & 127); }

__device__ __forceinline__ void phase_prologue(const Frame& F0, const Args& args) {
    const Frame F = refresh(F0);
    const int gw = F.vcu * NWAVES + F.wave, NGW = F.G * NWAVES;
    unsigned char* ws = F.ws;
    {
        LAS float* sc = (LAS float*)(F.lds + RING_OFF);
        const float* c = args.in[1]; const float* cc = args.in[3];
        for (int i = F.tid; i < 5 * DM; i += NWAVES * 64) { const float v = i < 4 * DM ? c[i] : cc[i - 4 * DM]; sc[i] = v * sigm(v); }
        __syncthreads();
        const float* ada_w = args.in[4]; const float* ada_b = args.in[5];
        float* MOD = (float*)(ws + WS_MOD);
        for (int it = gw; it < 288 * 8; it += NGW) {
            const int cb = it >> 3, kc = it & 7, l = cb / 144, n0 = (cb % 144) * 128 + 2 * F.lane;
            const float* wp = ada_w + ((size_t)l * DM + (size_t)kc * 256) * MODW + n0;
            f32x2 a0 = {0.f, 0.f}, a1 = a0, a2 = a0, a3 = a0, a4 = a0;
            const LAS float* s = sc + kc * 256;
#pragma unroll 8
            for (int k = 0; k < 256; ++k) { const f32x2 w = *(const f32x2*)(wp + (size_t)k * MODW);
                a0 += w * s[k]; a1 += w * s[DM + k]; a2 += w * s[2 * DM + k]; a3 += w * s[3 * DM + k]; a4 += w * s[4 * DM + k]; }
            if (kc == 0) { const f32x2 b = *(const f32x2*)(ada_b + (size_t)l * MODW + n0); a0 += b; a1 += b; a2 += b; a3 += b; a4 += b; }
            float* mp = MOD + (size_t)l * 5 * MODW + n0;
            atomicAdd(mp + 0 * MODW, a0.x); atomicAdd(mp + 0 * MODW + 1, a0.y);
            atomicAdd(mp + 1 * MODW, a1.x); atomicAdd(mp + 1 * MODW + 1, a1.y);
            atomicAdd(mp + 2 * MODW, a2.x); atomicAdd(mp + 2 * MODW + 1, a2.y);
            atomicAdd(mp + 3 * MODW, a3.x); atomicAdd(mp + 3 * MODW + 1, a3.y);
            atomicAdd(mp + 4 * MODW, a4.x); atomicAdd(mp + 4 * MODW + 1, a4.y);
        }
        __syncthreads();
    }
    {
        f32x2* LAM = (f32x2*)(ws + WS_LAM); f32x2* LAMT = (f32x2*)(ws + WS_LAMT); bf16* BOP = (bf16*)(ws + WS_BOP); bf16* COP = (bf16*)(ws + WS_COP);
        const float *a_re = args.in[17], *a_im = args.in[18], *log_dt = args.in[19], *b_re = args.in[20], *b_im = args.in[21], *c_re = args.in[22], *c_im = args.in[23];
        for (int it = F.vcu * (NWAVES * 64) + F.tid; it < 2 * 2 * NGRP * NST; it += F.G * NWAVES * 64) {
            const int p = it & 63, ldg = it >> 6;
            const float ar = a_re[it], ai = a_im[it], dt = expf(log_dt[ldg]);
            const float er = expf(ar * dt), lr = er * cosf(ai * dt), li = er * sinf(ai * dt);
            LAM[it] = (f32x2){lr, li};
            float tr = lr, ti = li;
#pragma unroll
            for (int s = 0; s < 8; ++s) { const float nr = tr * tr - ti * ti, ni = 2.f * tr * ti; tr = nr; ti = ni; }
            LAMT[it] = (f32x2){tr, ti};
            const float nr = lr - 1.f, ni = li, den = 1.f / (ar * ar + ai * ai);
            const float cr = (nr * ar + ni * ai) * den, ci = (ni * ar - nr * ai) * den;
            const int jj = p & 31, hi = p >> 5;
            for (int c = 0; c < 16; ++c) {
                const float br = b_re[(size_t)it * 16 + c], bi = b_im[(size_t)it * 16 + c];
                const float vr = cr * br - ci * bi, vi = cr * bi + ci * br;
                const int lane = jj + 32 * (c >> 3), j = c & 7;
                BOP[(((size_t)ldg * 4 + (hi ? 1 : 0)) * 64 + lane) * 8 + j] = (bf16)(pkbf(vr, 0.f) & 0xffffu);
                BOP[(((size_t)ldg * 4 + (hi ? 3 : 2)) * 64 + lane) * 8 + j] = (bf16)(pkbf(vi, 0.f) & 0xffffu);
                const float cre = c_re[((size_t)ldg * 16 + c) * 64 + p], cim = c_im[((size_t)ldg * 16 + c) * 64 + p];
                const int kk = 4 * jj + (hi ? 2 : 0);
                const int ks = kk >> 5, q = (kk & 31) >> 3, j2 = kk & 7, lane2 = c + 16 * q;
                COP[(((size_t)ldg * 4 + ks) * 64 + lane2) * 8 + j2] = (bf16)(pkbf(cre, 0.f) & 0xffffu);
                COP[(((size_t)ldg * 4 + ks) * 64 + lane2) * 8 + j2 + 1] = (bf16)(pkbf(-cim, 0.f) & 0xffffu);
            }
        }
    }
    {
        LAS float* scr = (LAS float*)(F.lds + RING_OFF + F.wave * 16384);
        constexpr int I_UP = (DM / 64) * (2 * DFF / 32), I_DN = (DFF / 64) * (DM / 32), I_IN = (DM / 64) * (NIN / 32), I_CO = (CDIM / 64) * (DM / 32), I_GLU = (SDIM / 64) * (2 * DM / 32), I_OUT = (DM / 64) * (DM / 32);
        constexpr int I_LAYER = 2 * I_UP + 2 * I_DN + I_IN + I_CO + I_GLU + I_OUT;
        for (int it = gw; it < 2 * I_LAYER; it += NGW) {
            const int l = it / I_LAYER; int r = it % I_LAYER;
            unsigned char* wl = ws + WS_W + (size_t)l * W_LAYER;
            const float* W; int K, N, kind; bf16* WT;
            if (r < I_UP) { W = args.in[7] + (size_t)l * DM * 2 * DFF; K = DM; N = 2 * DFF; kind = 1; WT = (bf16*)(wl + WO_UP1); }
            else if ((r -= I_UP) < I_DN) { W = args.in[8] + (size_t)l * DFF * DM; K = DFF; N = DM; kind = 0; WT = (bf16*)(wl + WO_DN1); }
            else if ((r -= I_DN) < I_IN) { W = args.in[10] + (size_t)l * DM * NIN; K = DM; N = NIN; kind = 2; WT = (bf16*)(wl + WO_IN); }
            else if ((r -= I_IN) < I_CO) { W = args.in[16] + (size_t)l * CDIM * DM; K = CDIM; N = DM; kind = 0; WT = (bf16*)(wl + WO_CO); }
            else if ((r -= I_CO) < I_GLU) { W = args.in[25] + (size_t)l * SDIM * 2 * DM; K = SDIM; N = 2 * DM; kind = 1; WT = (bf16*)(wl + WO_GLU); }
            else if ((r -= I_GLU) < I_OUT) { W = args.in[27] + (size_t)l * DM * DM; K = DM; N = DM; kind = 0; WT = (bf16*)(wl + WO_OUT); }
            else if ((r -= I_OUT) < I_UP) { W = args.in[29] + (size_t)l * DM * 2 * DFF; K = DM; N = 2 * DFF; kind = 1; WT = (bf16*)(wl + WO_UP2); }
            else { r -= I_UP; W = args.in[30] + (size_t)l * DFF * DM; K = DFF; N = DM; kind = 0; WT = (bf16*)(wl + WO_DN2); }
            const int nblk = N / 32, kb = r / nblk, nb = r % nblk, n0 = 32 * nb;
            int drow0 = n0;
            if (kind == 1) drow0 = glu_row(n0, N / 2);
            else if (kind == 2 && n0 < 2048) drow0 = glu_row(n0, 1024);
            transpose_item(W, K, N, WT, 64 * kb, n0, drow0, scr, F.lane);
        }
    }
}

__device__ __forceinline__ void phase_norm(const Frame& F0, const float* src_lat, const float* src_ctx, const float* gain, const float* mod, bf16* H, int nrows) {
    const Frame F = refresh(F0);
    const int gw = F.vcu * NWAVES + F.wave, NGW = F.G * NWAVES;
    for (int row = gw; row < nrows; row += NGW) {
        const float* xr = (row < ML ? src_lat + (size_t)row * DM : src_ctx + (size_t)(row - ML) * DM) + 4 * F.lane;
        f32x4 v[8]; float ss = 0.f;
#pragma unroll
        for (int j = 0; j < 8; ++j) { v[j] = *(const f32x4*)(xr + 256 * j); ss += (v[j].x * v[j].x + v[j].y * v[j].y) + (v[j].z * v[j].z + v[j].w * v[j].w); }
        const float rstd = 1.0f / sqrtf(wave_sum(ss) * (1.0f / DM) + EPS);
        const int mrow = row < ML ? (row >> 11) : 4;
        const float* sh = mod + (size_t)mrow * MODW + 4 * F.lane; const float* gp = gain + 4 * F.lane;
        bf16* orow = H + (size_t)row * DM + 4 * F.lane;
#pragma unroll
        for (int j = 0; j < 8; ++j) {
            const f32x4 g4 = *(const f32x4*)(gp + 256 * j), s4 = *(const f32x4*)(sh + 256 * j), c4 = *(const f32x4*)(sh + DM + 256 * j);
            const f32x4 o = (v[j] * rstd * g4) * (c4 + 1.0f) + s4;
            u32x2 w; w.x = pkbf(o.x, o.y); w.y = pkbf(o.z, o.w);
            *(u32x2*)(orow + 256 * j) = w;
        }
    }
}
__device__ __forceinline__ void phase_final(const Frame& F0, const float* X, const float* gain, float* out) {
    const Frame F = refresh(F0);
    const int gw = F.vcu * NWAVES + F.wave, NGW = F.G * NWAVES;
    for (int row = gw; row < ML; row += NGW) {
        const float* xr = X + (size_t)row * DM + 4 * F.lane;
        f32x4 v[8]; float ss = 0.f;
#pragma unroll
        for (int j = 0; j < 8; ++j) { v[j] = *(const f32x4*)(xr + 256 * j); ss += (v[j].x * v[j].x + v[j].y * v[j].y) + (v[j].z * v[j].z + v[j].w * v[j].w); }
        const float rstd = 1.0f / sqrtf(wave_sum(ss) * (1.0f / DM) + EPS);
        float* orow = out + (size_t)row * DM + 4 * F.lane; const float* gp = gain + 4 * F.lane;
#pragma unroll
        for (int j = 0; j < 8; ++j) *(f32x4*)(orow + 256 * j) = v[j] * rstd * *(const f32x4*)(gp + 256 * j);
    }
}

__device__ __forceinline__ void phase_conv(const Frame& F0, const bf16* UCONV, const float* dw, const float* db, const float* lng, const float* lnb, bf16* CONVACT, int nunits) {
    const Frame F = refresh(F0);
    LAS float* red = (LAS float*)(F.lds + RING_OFF);
    const int ch = 2 * F.tid;
    const f32x2 bias = *(const f32x2*)(db + ch), g2 = *(const f32x2*)(lng + ch), b2 = *(const f32x2*)(lnb + ch);
    for (int unit = F.vcu; unit < nunits; unit += F.G) {
        const int tok0 = unit * 16;
        const bool is_ctx = tok0 >= ML;
        f32x2 o[16];
#pragma unroll
        for (int i = 0; i < 16; ++i) o[i] = bias;
        if (is_ctx || F.tid < 256) {
            const int base = is_ctx ? (ML + ((tok0 - ML) & ~255)) : (tok0 & ~63), len = is_ctx ? 256 : 64, p0 = tok0 - base;
            const bf16* up = UCONV + (size_t)base * CDIM + ch;
#pragma unroll 1
            for (int k = 0; k < CONVK; ++k) {
                const f32x2 wk = *(const f32x2*)(dw + (size_t)k * CDIM + ch);
#pragma unroll
                for (int i = 0; i < 16; ++i) {
                    const int pos = p0 + i + k - 15; const bool ok = pos >= 0 && pos < len; const int pc = pos < 0 ? 0 : (pos >= len ? len - 1 : pos);
                    const unsigned x = *(const unsigned*)(up + (size_t)pc * CDIM);
                    const f32x2 v = {ok ? bf_lo(x) : 0.f, ok ? bf_hi(x) : 0.f};
                    o[i] += wk * v;
                }
            }
        } else {
            const int r = (tok0 >> 6) & 31;
            const bf16* up = UCONV + (size_t)tok0 * CDIM + ch;
            const int klo = r < 15 ? 15 - r : 0, khi = r > 16 ? 47 - r : CONVK;
#pragma unroll 1
            for (int k = klo; k < khi; ++k) {
                const f32x2 wk = *(const f32x2*)(dw + (size_t)k * CDIM + ch);
                const bf16* uk = up + (ptrdiff_t)(k - 15) * 64 * CDIM;
#pragma unroll
                for (int i = 0; i < 16; ++i) { const unsigned x = *(const unsigned*)(uk + (size_t)i * CDIM); o[i] += wk * (f32x2){bf_lo(x), bf_hi(x)}; }
            }
        }
        float s1[16], s2[16];
#pragma unroll
        for (int i = 0; i < 16; ++i) { s1[i] = wave_sum(o[i].x + o[i].y); s2[i] = wave_sum(o[i].x * o[i].x + o[i].y * o[i].y); }
        if (F.lane == 0) {
#pragma unroll
            for (int i = 0; i < 16; ++i) { red[F.wave * 32 + i] = s1[i]; red[F.wave * 32 + 16 + i] = s2[i]; }
        }
        __syncthreads();
        if (F.tid < 32) { float t = 0.f;
#pragma unroll
            for (int wv = 0; wv < 8; ++wv) t += red[wv * 32 + F.tid];
            red[256 + F.tid] = t; }
        __syncthreads();
#pragma unroll
        for (int i = 0; i < 16; ++i) {
            const float mean = red[256 + i] * (1.0f / CDIM), var = red[256 + 16 + i] * (1.0f / CDIM) - mean * mean;
            const float rstd = 1.0f / sqrtf(fmaxf(var, 0.f) + EPS);
            const float y0 = (o[i].x - mean) * rstd * g2.x + b2.x, y1 = (o[i].y - mean) * rstd * g2.y + b2.y;
            *(unsigned*)(CONVACT + (size_t)(tok0 + i) * CDIM + ch) = pkbf(y0 * sigm(y0), y1 * sigm(y1));
        }
        __syncthreads();
    }
}

__device__ __forceinline__ int ssm_row(int b, int q, int d, int i) {
    return q == 0 ? ML + b * CTXL + (d ? 255 - i : i) : b * SEQ + (d ? (8 - q) * 256 + 255 - i : (q - 1) * 256 + i);
}
constexpr int SSM_RS = 272;
template <bool PASS2>
__device__ __forceinline__ void ssm_task(const Frame& F, int l, int d, int bp, int g, int q, const bf16* SSMIN, f32x2* E, float* Y) {
    const unsigned char* ws = F.ws;
    const int lane = F.lane, jj = lane & 31, half = lane >> 5, ldg = (l * 2 + d) * 64 + g;
    const f32x2* LAM = (const f32x2*)(ws + WS_LAM) + (size_t)ldg * 64;
    const f32x2 lam0 = LAM[jj], lam1 = LAM[32 + jj];
    pg8::bf16x8 bfr[4];
    { const pg8::bf16x8* bop = (const pg8::bf16x8*)(ws + WS_BOP) + (size_t)ldg * 4 * 64 + lane;
#pragma unroll
      for (int nb = 0; nb < 4; ++nb) bfr[nb] = bop[nb * 64]; }
    pg8::bf16x8 cfr[4];
    if (PASS2) { const pg8::bf16x8* cop = (const pg8::bf16x8*)(ws + WS_COP) + (size_t)ldg * 4 * 64 + lane;
#pragma unroll
      for (int ks = 0; ks < 4; ++ks) cfr[ks] = cop[ks * 64]; }
    float h0r = 0.f, h0i = 0.f, h1r = 0.f, h1i = 0.f;
    const int b = 2 * bp + half;
    f32x2* Eb = E + ((size_t)((d * 4 + b) * 64 + g) * 9) * 64;
    if (PASS2) {
        const f32x2* LAMT = (const f32x2*)(ws + WS_LAMT) + (size_t)ldg * 64;
        const f32x2 t0 = LAMT[jj], t1 = LAMT[32 + jj];
        for (int qq = 0; qq < q; ++qq) {
            const f32x2 e0 = Eb[qq * 64 + jj], e1 = Eb[qq * 64 + 32 + jj];
            const float n0r = t0.x * h0r - t0.y * h0i + e0.x, n0i = t0.x * h0i + t0.y * h0r + e0.y; h0r = n0r; h0i = n0i;
            const float n1r = t1.x * h1r - t1.y * h1i + e1.x, n1i = t1.x * h1i + t1.y * h1r + e1.y; h1r = n1r; h1i = n1i;
        }
    }
    const int iA = lane & 31, halfA = (iA >> 2) & 1, vA = 4 * (iA >> 3) + (iA & 3), bA = 2 * bp + halfA;
    const bf16* ucol = SSMIN + g * 16 + 8 * (lane >> 5);
    LAS unsigned char* img = F.lds + RING_OFF + F.wave * (32 * SSM_RS);
    for (int blk = 0; blk < 16; ++blk) {
        const pg8::bf16x8 a = *(const pg8::bf16x8*)(ucol + (size_t)ssm_row(bA, q, d, blk * 16 + vA) * SDIM);
        f32x16 acc[4];
#pragma unroll
        for (int nb = 0; nb < 4; ++nb) { f32x16 z;
#pragma unroll
            for (int e = 0; e < 16; ++e) z[e] = 0.f;
            acc[nb] = __builtin_amdgcn_mfma_f32_32x32x16_bf16(a, bfr[nb], z, 0, 0, 0); }
#pragma unroll
        for (int v = 0; v < 16; ++v) {
            const float n0r = lam0.x * h0r - lam0.y * h0i + acc[0][v], n0i = lam0.x * h0i + lam0.y * h0r + acc[2][v]; h0r = n0r; h0i = n0i;
            const float n1r = lam1.x * h1r - lam1.y * h1i + acc[1][v], n1i = lam1.x * h1i + lam1.y * h1r + acc[3][v]; h1r = n1r; h1i = n1i;
            if (PASS2) { u32x2 w; w.x = pkbf(h0r, h0i); w.y = pkbf(h1r, h1i); *(LAS u32x2*)(img + (half * 16 + v) * SSM_RS + 8 * jj) = w; }
        }
        if (PASS2) {
            LDS_WAIT(); asm volatile("" ::: "memory");
            pg8::f32x4 yacc[2];
#pragma unroll
            for (int tb = 0; tb < 2; ++tb) { yacc[tb] = (pg8::f32x4){0.f, 0.f, 0.f, 0.f};
#pragma unroll
                for (int ks = 0; ks < 4; ++ks) { const pg8::bf16x8 af = *(const LAS pg8::bf16x8*)(img + (tb * 16 + (lane & 15)) * SSM_RS + (32 * ks + 8 * (lane >> 4)) * 2);
                    yacc[tb] = __builtin_amdgcn_mfma_f32_16x16x32_bf16(af, cfr[ks], yacc[tb], 0, 0, 0); } }
            LDS_WAIT(); asm volatile("" ::: "memory");
            const int c = lane & 15, q4 = lane >> 4;
#pragma unroll
            for (int tb = 0; tb < 2; ++tb)
#pragma unroll
                for (int v = 0; v < 4; ++v) Y[(size_t)ssm_row(2 * bp + tb, q, d, blk * 16 + 4 * q4 + v) * SDIM + g * 16 + c] = yacc[tb][v];
        }
    }
    if (!PASS2) { Eb[q * 64 + jj] = (f32x2){h0r, h0i}; Eb[q * 64 + 32 + jj] = (f32x2){h1r, h1i}; }
}
template <bool PASS2>
__device__ __forceinline__ void phase_ssm(const Frame& F0, int l, const bf16* SSMIN, f32x2* E, float* YF, float* YB, int q_lo, int q_hi) {
    const Frame F = refresh(F0);
    const int gw = F.vcu * NWAVES + F.wave, NGW = F.G * NWAVES, nq = q_hi - q_lo;
    for (int t = gw; t < 256 * nq; t += NGW) {
        const int d = t & 1, bp = (t >> 1) & 1, g = (t >> 2) & 63, q = q_lo + (t >> 8);
        ssm_task<PASS2>(F, l, d, bp, g, q, SSMIN, E, d ? YB : YF);
    }
}
__device__ __forceinline__ void phase_ssm_post(const Frame& F0, const float* YF, const float* YB, const bf16* SSMIN, const float* ssm_d, bf16* SSMACT, int nrows) {
    const Frame F = refresh(F0);
    const size_t n8 = (size_t)nrows * SDIM / 8;
    for (size_t i = (size_t)F.vcu * (NWAVES * 64) + F.tid; i < n8; i += (size_t)F.G * NWAVES * 64) {
        const size_t e = i * 8; const int c = (int)(e & (SDIM - 1));
        const pg8::f32x4 f0 = *(const pg8::f32x4*)(YF + e), f1 = *(const pg8::f32x4*)(YF + e + 4), b0 = *(const pg8::f32x4*)(YB + e), b1 = *(const pg8::f32x4*)(YB + e + 4);
        const pg8::f32x4 d0 = *(const pg8::f32x4*)(ssm_d + c), d1 = *(const pg8::f32x4*)(ssm_d + c + 4);
        const pg8::u32x4 uw = *(const pg8::u32x4*)(SSMIN + e);
        const pg8::f32x4 y0 = f0 + b0 + d0 * pg8::bf4_lo(uw, 0), y1 = f1 + b1 + d1 * pg8::bf4_lo(uw, 1);
        pg8::u32x4 w; w.x = pkbf(gelu_tanh(y0[0]), gelu_tanh(y0[1])); w.y = pkbf(gelu_tanh(y0[2]), gelu_tanh(y0[3])); w.z = pkbf(gelu_tanh(y1[0]), gelu_tanh(y1[1])); w.w = pkbf(gelu_tanh(y1[2]), gelu_tanh(y1[3]));
        *(pg8::u32x4*)(SSMACT + e) = w;
    }
}

constexpr int PH_PER_LAYER = 14, PH_FINAL = 1 + 2 * PH_PER_LAYER, NPHASES = PH_FINAL + 1;
__global__ void __launch_bounds__(NWAVES * 64, 2) fwd_kernel(Args args) {
    extern __shared__ __attribute__((aligned(16))) unsigned char lds[];
    Frame F;
    F.lds = (LAS unsigned char*)lds;
    F.tid = threadIdx.x; F.lane = F.tid & 63; F.wave = __builtin_amdgcn_readfirstlane(F.tid >> 6);
    F.G = gridDim.x; { const int bx = blockIdx.x; F.vcu = (F.G % 8 == 0) ? (bx % 8) * (F.G / 8) + bx / 8 : bx; }
    F.ws = args.ws;
    unsigned char* ws = args.ws;
    gu32* ctl = (gu32*)(ws + WS_CTL);
    volatile LAS unsigned* MISC = (volatile LAS unsigned*)(F.lds + MISC_OFF);
    for (int u = F.tid; u < (LDS_BYTES - LDSCTL_OFF) / 4; u += NWAVES * 64) ((LAS unsigned*)(F.lds + LDSCTL_OFF))[u] = 0u;
    __syncthreads();
    const int lo = args.ph_lo, hi = args.ph_hi;
    XcdBarrier bar; bar.bar = (unsigned*)(ctl + CW_BAR); bar.x = 0; bar.st = nullptr;
    if (hi - lo > 1) bar = xcd_barrier_post((unsigned*)(ctl + CW_BAR), MISC + 8);
#ifndef PHMASK
#define PHMASK 0xFFFFFFFFu
#endif
#define PHON(s) (((PHMASK) >> (s)) & 1u)
#define IN(k) (lo <= (k) && (k) < hi)
#define SEAM(k) do { if (IN((k) + 1)) xcd_barrier(bar); } while (0)

    float* MOD = (float*)(ws + WS_MOD);
    float* X = (float*)(ws + WS_X); bf16* H = (bf16*)(ws + WS_H); bf16* ACT = (bf16*)(ws + WS_ACT);
    bf16* UCONV = (bf16*)(ws + WS_UCONV); bf16* SSMIN = (bf16*)(ws + WS_SSMIN); bf16* GATES = (bf16*)(ws + WS_GATES);
    bf16* CONVACT = (bf16*)(ws + WS_CONVACT); bf16* SSMACT = (bf16*)(ws + WS_SSMACT);
    float* YF = (float*)(ws + WS_YF); float* YB = (float*)(ws + WS_YB); bf16* T1 = (bf16*)(ws + WS_T1); bf16* MIX = (bf16*)(ws + WS_MIX); f32x2* E = (f32x2*)(ws + WS_E);

    if (PHON(14) && IN(0)) { phase_prologue(F, args); SEAM(0); }

    for (int l = 0; l < 2; ++l) {
        const int pb = 1 + PH_PER_LAYER * l;
        const bool last = (l == 1);
        unsigned char* wl = ws + WS_W + (size_t)l * W_LAYER;
        const float* modl = MOD + (size_t)l * 5 * MODW;
        const float* x_lat = l == 0 ? args.in[0] : X; const float* x_ctx = l == 0 ? args.in[2] : X + (size_t)ML * DM;
        float* Xc = X + (size_t)ML * DM;
        if (PHON(0) && IN(pb + 0)) { phase_norm(F, x_lat, x_ctx, args.in[6] + (size_t)l * DM, modl + 0 * DM, H, MT); SEAM(pb + 0); }
        if (PHON(1) && IN(pb + 1)) { pg8::Gemm g{H, (const bf16*)(wl + WO_UP1), MT, 2 * DFF, DM}; pg8::Order S; S.init(MT, 2 * DFF, F.G, (int)blockIdx.x);
            pg8::EpiSwiGLU Ep{ACT, DFF}; pg8::gemm_phase<pg8::EpiSwiGLU, pg8::Order, true, true>(F.lds + RING_OFF, g, S, Ep); SEAM(pb + 1); }
        if (PHON(2) && IN(pb + 2)) { pg8::Gemm g{ACT, (const bf16*)(wl + WO_DN1), MT, DM, DFF}; pg8::Order S; S.init(MT, DM, F.G, (int)blockIdx.x);
            pg8::EpiResid Ep{x_lat, x_ctx, X, modl + 2 * DM, 0.5f}; pg8::gemm_phase<pg8::EpiResid, pg8::Order, true, true>(F.lds + RING_OFF, g, S, Ep); SEAM(pb + 2); }
        if (PHON(3) && IN(pb + 3)) { phase_norm(F, X, Xc, args.in[9] + (size_t)l * DM, modl + 3 * DM, H, MT); SEAM(pb + 3); }
        if (PHON(4) && IN(pb + 4)) { pg8::Gemm g{H, (const bf16*)(wl + WO_IN), MT, NIN, DM}; pg8::Order S;
            if (!last) S.init(MT, NIN, F.G, (int)blockIdx.x); else { S.init(ML, NIN, F.G, (int)blockIdx.x); S.extra(16, 32, 8, 4); }
            pg8::EpiProj Ep{UCONV, SSMIN, GATES, args.in[11] + (size_t)l * NIN}; pg8::gemm_phase<pg8::EpiProj, pg8::Order, true, true>(F.lds + RING_OFF, g, S, Ep); SEAM(pb + 4); }
        if (PHON(5) && IN(pb + 5)) {
            phase_conv(F, UCONV, args.in[12] + (size_t)l * CONVK * CDIM, args.in[13] + (size_t)l * CDIM, args.in[14] + (size_t)l * CDIM, args.in[15] + (size_t)l * CDIM, CONVACT, (last ? ML : MT) / 16);
            phase_ssm<false>(F, l, SSMIN, E, YF, YB, 0, 8);
            SEAM(pb + 5); }
        if (PHON(6) && IN(pb + 6)) { phase_ssm<true>(F, l, SSMIN, E, YF, YB, last ? 1 : 0, 9); SEAM(pb + 6); }
        if (PHON(7) && IN(pb + 7)) { phase_ssm_post(F, YF, YB, SSMIN, args.in[24] + (size_t)l * SDIM, SSMACT, last ? ML : MT); SEAM(pb + 7); }
        const int Mx = last ? ML : MT;
        if (PHON(8) && IN(pb + 8)) { pg8::Gemm g{SSMACT, (const bf16*)(wl + WO_GLU), Mx, 2 * DM, SDIM}; pg8::Order S; S.init(Mx, 2 * DM, F.G, (int)blockIdx.x);
            pg8::EpiGluGate Ep{T1, GATES, args.in[26] + (size_t)l * 2 * DM}; pg8::gemm_phase<pg8::EpiGluGate, pg8::Order, true, true>(F.lds + RING_OFF, g, S, Ep); SEAM(pb + 8); }
        if (PHON(9) && IN(pb + 9)) { pg8::Gemm g{CONVACT, (const bf16*)(wl + WO_CO), Mx, DM, CDIM}; pg8::Order S; S.init(Mx, DM, F.G, (int)blockIdx.x);
            pg8::EpiConvMix Ep{MIX, GATES, T1}; pg8::gemm_phase<pg8::EpiConvMix, pg8::Order, true, true>(F.lds + RING_OFF, g, S, Ep); SEAM(pb + 9); }
        if (PHON(10) && IN(pb + 10)) { pg8::Gemm g{MIX, (const bf16*)(wl + WO_OUT), Mx, DM, DM}; pg8::Order S; S.init(Mx, DM, F.G, (int)blockIdx.x);
            pg8::EpiResid Ep{X, Xc, X, modl + 5 * DM, 1.0f}; pg8::gemm_phase<pg8::EpiResid, pg8::Order, true, true>(F.lds + RING_OFF, g, S, Ep); SEAM(pb + 10); }
        if (PHON(11) && IN(pb + 11)) { phase_norm(F, X, Xc, args.in[28] + (size_t)l * DM, modl + 6 * DM, H, Mx); SEAM(pb + 11); }
        if (PHON(12) && IN(pb + 12)) { pg8::Gemm g{H, (const bf16*)(wl + WO_UP2), Mx, 2 * DFF, DM}; pg8::Order S; S.init(Mx, 2 * DFF, F.G, (int)blockIdx.x);
            pg8::EpiSwiGLU Ep{ACT, DFF}; pg8::gemm_phase<pg8::EpiSwiGLU, pg8::Order, true, true>(F.lds + RING_OFF, g, S, Ep); SEAM(pb + 12); }
        if (PHON(13) && IN(pb + 13)) { pg8::Gemm g{ACT, (const bf16*)(wl + WO_DN2), Mx, DM, DFF}; pg8::Order S; S.init(Mx, DM, F.G, (int)blockIdx.x);
            pg8::EpiResid Ep{X, Xc, X, modl + 8 * DM, 0.5f}; pg8::gemm_phase<pg8::EpiResid, pg8::Order, true, true>(F.lds + RING_OFF, g, S, Ep); SEAM(pb + 13); }
    }
    if (PHON(15) && IN(PH_FINAL)) phase_final(F, X, args.in[31], args.out);
#undef IN
#undef SEAM
}

extern "C" void kernel_launch(void* const* d_in, const int* in_sizes, int n_in, void* d_out, int out_size, void* d_ws, size_t ws_size, hipStream_t stream) {
    static int grid = 0;
    if (grid == 0) {
        if (n_in != 32 || in_sizes[0] != ML * DM || out_size != ML * DM || ws_size < WS_END) { fprintf(stderr, "kernel_launch: unexpected shapes (n_in %d, in0 %d, out %d, ws %zu); nothing launched\n", n_in, n_in > 0 ? in_sizes[0] : -1, out_size, ws_size); grid = -1; return; }
        int dev = 0, cus = 0, per_cu = 0;
        if (hipGetDevice(&dev) != hipSuccess || hipDeviceGetAttribute(&cus, hipDeviceAttributeMultiprocessorCount, dev) != hipSuccess) { grid = -1; return; }
        if (hipFuncSetAttribute((const void*)fwd_kernel, hipFuncAttributeMaxDynamicSharedMemorySize, LDS_BYTES) != hipSuccess) { fprintf(stderr, "kernel_launch: hipFuncSetAttribute failed\n"); grid = -1; return; }
        if (hipOccupancyMaxActiveBlocksPerMultiprocessor(&per_cu, (const void*)fwd_kernel, NWAVES * 64, LDS_BYTES) != hipSuccess || per_cu < 1) fprintf(stderr, "kernel_launch: occupancy query reports %d blocks per CU\n", per_cu);
        (void)hipGetLastError();
        grid = cus;
    }
    if (grid < 0) return;
    if (hipMemsetAsync((char*)d_ws + WS_CTL, 0, ZERO_BYTES, stream) != hipSuccess) { fprintf(stderr, "kernel_launch: memset failed\n"); return; }
    Args a{};
    for (int i = 0; i < 32; ++i) a.in[i] = (const float*)d_in[i];
    a.out = (float*)d_out; a.ws = (unsigned char*)d_ws;
#if MK_PER_PHASE
    for (int p = 0; p < NPHASES; ++p) { a.ph_lo = p; a.ph_hi = p + 1; hipLaunchKernelGGL(fwd_kernel, dim3(grid), dim3(NWAVES * 64), LDS_BYTES, stream, a); }
#else
    a.ph_lo = 0; a.ph_hi = NPHASES; hipLaunchKernelGGL(fwd_kernel, dim3(grid), dim3(NWAVES * 64), LDS_BYTES, stream, a);
#endif
    const hipError_t le = hipPeekAtLastError();
    if (le != hipSuccess) fprintf(stderr, "kernel_launch: launch failed: %s\n", hipGetErrorName(le));
}
```

```cpp
#include <hip/hip_runtime.h>
#include <cstdio>
#include <cstdint>
namespace pg8 {
#define PG8_LAS __attribute__((address_space(3)))
typedef unsigned short bf16_t;
typedef short bf16x8 __attribute__((ext_vector_type(8)));
typedef float f32x4 __attribute__((ext_vector_type(4)));
typedef unsigned u32x4 __attribute__((ext_vector_type(4)));
constexpr int BM = 256, BK = 64, HALF = 128, HTB = HALF * BK * 2  , STAGE_BYTES = 8 * HTB, NXCD = 8, WGM = 8;

__host__ __device__ __forceinline__ int lds_byte(int r, int c) { const int st = (r >> 4) * 2 + (c >> 5), rr = r & 15, cc = c & 31, ob = rr * 64 + cc * 2; return st * 1024 + (ob ^ (((ob >> 9) & 1) << 5)); }
__host__ __device__ __forceinline__ void stage_rc(int b, int& R, int& C) { const int st = b / 1024, sb = b % 1024, swz = sb ^ (((sb >> 9) & 1) << 5); R = (st >> 1) * 16 + swz / 64; C = (st & 1) * 32 + (swz % 64) / 2; }
__host__ __device__ __forceinline__ int perm32(int rho) { const int n = rho >> 4, i = rho & 15; return 8 * (i >> 2) + 4 * n + (i & 3); }

struct Unit { int pm, pn, k0, nt; };
struct Gemm { const bf16_t* A; const bf16_t* Bt; int M, N, K; int a_tiled; };

__device__ __forceinline__ unsigned cvt_pk_bf16(float lo, float hi) { unsigned r; asm volatile("v_cvt_pk_bf16_f32 %0, %1, %2" : "=v"(r) : "v"(lo), "v"(hi)); return r; }
struct Order {
    int nM, nN, nwg, G, c, ntK, ex_n, ex_pm0, ex_pn0, ex_w, ex_split;
    __device__ __forceinline__ void init(int M, int N, int K, int G_, int c_) { nM = M / BM; nN = N / BM; nwg = nM * nN; G = G_; c = c_; ntK = K / BK; ex_n = 0; ex_pm0 = 0; ex_pn0 = 0; ex_w = 1; ex_split = 1; }
    __device__ __forceinline__ void extra(int n_units, int pm0, int pn0, int w, int split) { ex_n = n_units * split; ex_pm0 = pm0; ex_pn0 = pn0; ex_w = w; ex_split = split; }
    __device__ __forceinline__ bool next(int i, Unit& u) const {
        const long L = (long)i * G + c;
        const bool is_main = L < nwg;
        const int e = is_main ? 0 : (int)(L - nwg);
        const bool ok = is_main || e < ex_n;
        int wgid = is_main ? (int)L : 0; { const int q = nwg / NXCD, r = nwg % NXCD, xcd = wgid % NXCD, off = wgid / NXCD; wgid = (xcd < r ? xcd * (q + 1) : r * (q + 1) + (xcd - r) * q) + off; }
        const int nig = WGM * nN, gid = wgid / nig, fm = gid * WGM, gsz = (nM - fm) < WGM ? (nM - fm) : WGM;
        const int pm_m = fm + ((wgid % nig) % gsz), pn_m = (wgid % nig) / gsz;
        const int piece = e % ex_split, ue = e / ex_split, ntp = ntK / ex_split;
        const int pm_e = ex_pm0 + ue / ex_w, pn_e = ex_pn0 + ue % ex_w;
        Unit r; r.pm = is_main ? pm_m : pm_e; r.pn = is_main ? pn_m : pn_e; r.k0 = is_main ? 0 : piece * ntp; r.nt = is_main ? ntK : ntp;
        u = r; return ok;
    }
    __device__ __forceinline__ void a_ready(const Unit&) const {}
    __device__ __forceinline__ void done(const Unit&) const {}
};

__device__ __forceinline__ size_t tiled_off(int row, int col, int K) { return ((size_t)(row >> 7) * (size_t)(K >> 6) + (size_t)(col >> 6)) * 8192 + (size_t)((row & 127) * 64 + (col & 63)); }
__device__ __forceinline__ float fsigmoid(float x) { return __builtin_amdgcn_rcpf(1.0f + __expf(-x)); }
__device__ __forceinline__ float fsilu(float x) { return x * fsigmoid(x); }
__device__ __forceinline__ f32x4 bf4_lo(u32x4 w, int half) {
    const unsigned a = half ? w.z : w.x, b = half ? w.w : w.y;
    return (f32x4){__uint_as_float(a << 16), __uint_as_float(a & 0xffff0000u), __uint_as_float(b << 16), __uint_as_float(b & 0xffff0000u)};
}

struct EpiSwiGLU {
    static constexpr bool PERM = true, AFTER_DRAIN = false;
    bf16_t* O; int ldc;
    __device__ __forceinline__ void operator()(const f32x4 (&acc)[2][2][4][2], const Unit& u, int wr, int wc, int fr, int fq) const {
        const int row0 = u.pm * BM + wr * 64 + fr, col0 = u.pn * HALF + wc * 32 + 8 * fq;
#pragma unroll
        for (int ai = 0; ai < 2; ++ai)
#pragma unroll
            for (int m = 0; m < 4; ++m) {
                bf16_t* rowp = O + tiled_off(row0 + ai * HALF + m * 16, col0, ldc);
                float r[8];
#pragma unroll
                for (int n = 0; n < 2; ++n)
#pragma unroll
                    for (int j = 0; j < 4; ++j) r[4 * n + j] = fsilu(acc[ai][1][m][n][j]) * acc[ai][0][m][n][j];
                u32x4 w; w.x = cvt_pk_bf16(r[0], r[1]); w.y = cvt_pk_bf16(r[2], r[3]); w.z = cvt_pk_bf16(r[4], r[5]); w.w = cvt_pk_bf16(r[6], r[7]);
                *(u32x4*)rowp = w;
            }
    }
};

struct EpiResid {
    static constexpr bool PERM = false, AFTER_DRAIN = false;
    const float* base_lat; const float* base_ctx; float* out; const float* gate; float scale;
    float* slab; int ntK;
    __device__ __forceinline__ void operator()(const f32x4 (&acc)[2][2][4][2], const Unit& u, int wr, int wc, int fr, int fq) const {
        const int row0 = u.pm * BM + wr * 64 + fr, col0 = u.pn * BM + wc * 32 + 4 * fq;
        if (u.nt != ntK) {
            float* sp = slab + ((size_t)(u.k0 / u.nt) * 1024 + (size_t)(row0 - 8192)) * 2048 + col0;
#pragma unroll
            for (int ai = 0; ai < 2; ++ai)
#pragma unroll
                for (int m = 0; m < 4; ++m)
#pragma unroll
                    for (int bj = 0; bj < 2; ++bj)
#pragma unroll
                        for (int n = 0; n < 2; ++n) *(f32x4*)(sp + (size_t)(ai * HALF + m * 16) * 2048 + bj * HALF + n * 16) = acc[ai][bj][m][n];
            return;
        }
        const int mrow = u.pm < 32 ? (u.pm >> 3) : 4;
        f32x4 gv[2][2];
#pragma unroll
        for (int bj = 0; bj < 2; ++bj)
#pragma unroll
            for (int n = 0; n < 2; ++n) gv[bj][n] = *(const f32x4*)(gate + (size_t)mrow * 18432 + col0 + bj * HALF + n * 16) * scale;
#pragma unroll
        for (int ai = 0; ai < 2; ++ai)
#pragma unroll
            for (int m = 0; m < 4; ++m) {
                const int r = row0 + ai * HALF + m * 16;
                const float* bp = (r < 8192 ? base_lat + (size_t)r * 2048 : base_ctx + (size_t)(r - 8192) * 2048) + col0;
                float* op = out + (size_t)r * 2048 + col0;
#pragma unroll
                for (int bj = 0; bj < 2; ++bj)
#pragma unroll
                    for (int n = 0; n < 2; ++n) *(f32x4*)(op + bj * HALF + n * 16) = *(const f32x4*)(bp + bj * HALF + n * 16) + gv[bj][n] * acc[ai][bj][m][n];
            }
    }
};

struct EpiProj {
    static constexpr bool PERM = true, AFTER_DRAIN = false;
    bf16_t* UCONV; bf16_t* SSMIN; bf16_t* GATES; const float* bias;
    __device__ __forceinline__ void operator()(const f32x4 (&acc)[2][2][4][2], const Unit& u, int wr, int wc, int fr, int fq) const {
        const int row0 = u.pm * BM + wr * 64 + fr, jj = wc * 32 + 8 * fq;
        if (u.pn < 8) {
            const int col0 = u.pn * HALF + jj;
            f32x4 ba[2], bg[2];
#pragma unroll
            for (int n = 0; n < 2; ++n) { ba[n] = *(const f32x4*)(bias + col0 + 4 * n); bg[n] = *(const f32x4*)(bias + 1024 + col0 + 4 * n); }
#pragma unroll
            for (int ai = 0; ai < 2; ++ai)
#pragma unroll
                for (int m = 0; m < 4; ++m) {
                    bf16_t* rowp = UCONV + (size_t)(row0 + ai * HALF + m * 16) * 1024 + col0;
                    float r[8];
#pragma unroll
                    for (int n = 0; n < 2; ++n)
#pragma unroll
                        for (int j = 0; j < 4; ++j) r[4 * n + j] = (acc[ai][0][m][n][j] + ba[n][j]) * fsigmoid(acc[ai][1][m][n][j] + bg[n][j]);
                    u32x4 w; w.x = cvt_pk_bf16(r[0], r[1]); w.y = cvt_pk_bf16(r[2], r[3]); w.z = cvt_pk_bf16(r[4], r[5]); w.w = cvt_pk_bf16(r[6], r[7]);
                    *(u32x4*)rowp = w;
                }
        } else {
            const bool is_gate = u.pn >= 12;
            bf16_t* O = is_gate ? GATES : SSMIN; const int ldc = is_gate ? 4096 : 1024;
            const int col0 = (is_gate ? (u.pn - 12) : (u.pn - 8)) * BM + jj, bcol0 = u.pn * BM + jj;
            f32x4 bv[2][2];
#pragma unroll
            for (int bj = 0; bj < 2; ++bj)
#pragma unroll
                for (int n = 0; n < 2; ++n) bv[bj][n] = *(const f32x4*)(bias + bcol0 + bj * HALF + 4 * n);
#pragma unroll
            for (int ai = 0; ai < 2; ++ai)
#pragma unroll
                for (int m = 0; m < 4; ++m) {
                    bf16_t* rowp = O + (size_t)(row0 + ai * HALF + m * 16) * ldc + col0;
#pragma unroll
                    for (int bj = 0; bj < 2; ++bj) {
                        f32x4 v0 = acc[ai][bj][m][0] + bv[bj][0], v1 = acc[ai][bj][m][1] + bv[bj][1];
                        if (is_gate) {
#pragma unroll
                            for (int j = 0; j < 4; ++j) { v0[j] = fsigmoid(v0[j]); v1[j] = fsigmoid(v1[j]); }
                        }
                        u32x4 w; w.x = cvt_pk_bf16(v0[0], v0[1]); w.y = cvt_pk_bf16(v0[2], v0[3]); w.z = cvt_pk_bf16(v1[0], v1[1]); w.w = cvt_pk_bf16(v1[2], v1[3]);
                        *(u32x4*)(rowp + bj * HALF) = w;
                    }
                }
        }
    }
};

struct EpiGluGate {
    static constexpr bool PERM = true, AFTER_DRAIN = false;
    bf16_t* T1; const bf16_t* GATES; const float* bias;
    __device__ __forceinline__ void operator()(const f32x4 (&acc)[2][2][4][2], const Unit& u, int wr, int wc, int fr, int fq) const {
        const int row0 = u.pm * BM + wr * 64 + fr, col0 = u.pn * HALF + wc * 32 + 8 * fq;
        f32x4 ba[2], bg[2];
#pragma unroll
        for (int n = 0; n < 2; ++n) { ba[n] = *(const f32x4*)(bias + col0 + 4 * n); bg[n] = *(const f32x4*)(bias + 2048 + col0 + 4 * n); }
#pragma unroll
        for (int ai = 0; ai < 2; ++ai)
#pragma unroll
            for (int m = 0; m < 4; ++m) {
                const size_t r = (size_t)(row0 + ai * HALF + m * 16);
                const u32x4 gw = *(const u32x4*)(GATES + r * 4096 + 2048 + col0);
                float rr[8];
#pragma unroll
                for (int n = 0; n < 2; ++n) { const f32x4 gs = bf4_lo(gw, n);
#pragma unroll
                    for (int j = 0; j < 4; ++j) rr[4 * n + j] = gs[j] * (acc[ai][0][m][n][j] + ba[n][j]) * fsigmoid(acc[ai][1][m][n][j] + bg[n][j]); }
                u32x4 w; w.x = cvt_pk_bf16(rr[0], rr[1]); w.y = cvt_pk_bf16(rr[2], rr[3]); w.z = cvt_pk_bf16(rr[4], rr[5]); w.w = cvt_pk_bf16(rr[6], rr[7]);
                *(u32x4*)(T1 + r * 2048 + col0) = w;
            }
    }
};

struct EpiConvMix {
    static constexpr bool PERM = true, AFTER_DRAIN = false;
    bf16_t* MIX; const bf16_t* GATES; const bf16_t* T1;
    __device__ __forceinline__ void operator()(const f32x4 (&acc)[2][2][4][2], const Unit& u, int wr, int wc, int fr, int fq) const {
        const int row0 = u.pm * BM + wr * 64 + fr, col0 = u.pn * BM + wc * 32 + 8 * fq;
#pragma unroll
        for (int ai = 0; ai < 2; ++ai)
#pragma unroll
            for (int m = 0; m < 4; ++m) {
                const size_t r = (size_t)(row0 + ai * HALF + m * 16);
#pragma unroll
                for (int bj = 0; bj < 2; ++bj) {
                    const u32x4 gw = *(const u32x4*)(GATES + r * 4096 + col0 + bj * HALF);
                    const u32x4 tw = *(const u32x4*)(T1 + r * 2048 + col0 + bj * HALF);
                    const f32x4 v0 = bf4_lo(gw, 0) * acc[ai][bj][m][0] + bf4_lo(tw, 0), v1 = bf4_lo(gw, 1) * acc[ai][bj][m][1] + bf4_lo(tw, 1);
                    u32x4 w; w.x = cvt_pk_bf16(v0[0], v0[1]); w.y = cvt_pk_bf16(v0[2], v0[3]); w.z = cvt_pk_bf16(v1[0], v1[1]); w.w = cvt_pk_bf16(v1[2], v1[3]);
                    *(u32x4*)(MIX + tiled_off((int)r, col0 + bj * HALF, 2048)) = w;
                }
            }
    }
};

template <class Epi, class Sched, bool ALIGN_EPI = false, bool SP2 = false>
__device__ __forceinline__ void gemm_phase(PG8_LAS unsigned char* lds, const Gemm g, const Sched& S, const Epi& E) {
    int tid_ = threadIdx.x; asm volatile("" : "+v"(tid_));
    const int tid = tid_, wid = __builtin_amdgcn_readfirstlane(tid >> 6), lane = tid & 63, wr = wid >> 2, wc = wid & 3, fr = lane & 15, fq = lane >> 4;
    const int K = g.K;
    unsigned voffA[2], voffB[2];
#pragma unroll
    for (int i = 0; i < 2; ++i) { int R, C; stage_rc(tid * 16 + i * 8192, R, C); const int Rb = Epi::PERM ? ((R & ~31) + perm32(R & 31)) : R;
        voffA[i] = (unsigned)(R * (g.a_tiled ? BK : K) + C) * 2u; voffB[i] = (unsigned)(Rb * BK + C) * 2u; }
    const size_t kstep = g.a_tiled ? (size_t)HTB : (size_t)(BK * 2);
    const size_t kstepB = (size_t)HTB;
    const size_t hstep = (size_t)HALF * K * 2;
    const size_t tstep = 2 * hstep;
    const unsigned ldsw = (unsigned)wid * 1024u;
    const int aoff = lds_byte(wr * 64 + fr, fq * 8), boff = lds_byte(wc * 32 + fr, fq * 8);
#define PG8_SA(b, h) (((b) * 2 + (h)) * HTB)
#define PG8_SB(b, h) ((4 + (b) * 2 + (h)) * HTB)
#define PG8_STAGE(bufoff, gbase, voff) do { _Pragma("unroll") for (int _i = 0; _i < 2; ++_i) \
        __builtin_amdgcn_global_load_lds((const unsigned*)((const char*)(gbase) + (voff)[_i]), (PG8_LAS unsigned*)(lds + (bufoff) + ldsw + _i * 8192), 16, 0, 0); } while (0)
#define PG8_LDA(dst, b, h) do { _Pragma("unroll") for (int m = 0; m < 4; ++m) _Pragma("unroll") for (int k = 0; k < 2; ++k) dst[m][k] = *(const PG8_LAS bf16x8*)(lds + PG8_SA(b, h) + aoff + m * 2048 + k * 1024); } while (0)
#define PG8_LDB(dst, b, h) do { _Pragma("unroll") for (int n = 0; n < 2; ++n) _Pragma("unroll") for (int k = 0; k < 2; ++k) dst[n][k] = *(const PG8_LAS bf16x8*)(lds + PG8_SB(b, h) + boff + n * 2048 + k * 1024); } while (0)
#define PG8_MMA(ai, bj, At, Bt) do { __builtin_amdgcn_s_setprio(1); _Pragma("unroll") for (int m = 0; m < 4; ++m) _Pragma("unroll") for (int n = 0; n < 2; ++n) _Pragma("unroll") for (int k = 0; k < 2; ++k) \
        acc[ai][bj][m][n] = __builtin_amdgcn_mfma_f32_16x16x32_bf16(Bt[n][k], At[m][k], acc[ai][bj][m][n], 0, 0, 0); __builtin_amdgcn_s_setprio(0); } while (0)
#define PG8_WAIT_V(n) asm volatile("s_waitcnt vmcnt(" #n ")" ::: "memory")
#define PG8_WAIT_L(n) asm volatile("s_waitcnt lgkmcnt(" #n ")" ::: "memory")
#define PG8_BAR __builtin_amdgcn_s_barrier()
#define PG8_SCHED __builtin_amdgcn_sched_barrier(0)
    Unit cur, nxt; int ui = 0;
    if (!S.next(0, cur)) return;
    f32x4 acc[2][2][4][2];
#pragma unroll
    for (int a = 0; a < 2; ++a)
#pragma unroll
        for (int b = 0; b < 2; ++b)
#pragma unroll
            for (int m = 0; m < 4; ++m)
#pragma unroll
                for (int n = 0; n < 2; ++n) acc[a][b][m][n] = (f32x4){0.f, 0.f, 0.f, 0.f};
    bf16x8 At[4][2], B0[2][2], B1[2][2];
    const char* cA = (const char*)g.A + (size_t)cur.pm * tstep + (size_t)cur.k0 * kstep; const char* cB = (const char*)g.Bt + (size_t)cur.pn * tstep + (size_t)cur.k0 * kstepB;
    S.a_ready(cur);
    if constexpr (SP2) {
        PG8_STAGE(PG8_SB(0, 0), cB, voffB); PG8_STAGE(PG8_SB(0, 1), cB + hstep, voffB); PG8_STAGE(PG8_SA(0, 0), cA, voffA); PG8_STAGE(PG8_SA(0, 1), cA + hstep, voffA);
        if (wr == 1) PG8_BAR;
        PG8_WAIT_V(2); PG8_BAR;
        PG8_STAGE(PG8_SB(1, 0), cB + kstepB, voffB); PG8_STAGE(PG8_SA(1, 0), cA + kstep, voffA); PG8_STAGE(PG8_SB(1, 1), cB + hstep + kstepB, voffB);
        PG8_WAIT_V(6); PG8_BAR;
    } else {
        PG8_STAGE(PG8_SB(0, 0), cB, voffB); PG8_STAGE(PG8_SA(0, 0), cA, voffA); PG8_STAGE(PG8_SB(0, 1), cB + hstep, voffB); PG8_STAGE(PG8_SA(0, 1), cA + hstep, voffA);
        if (wr == 1) PG8_BAR;
        PG8_WAIT_V(4); PG8_BAR;
        PG8_STAGE(PG8_SB(1, 0), cB + kstepB, voffB); PG8_STAGE(PG8_SA(1, 0), cA + kstep, voffA); PG8_STAGE(PG8_SB(1, 1), cB + hstep + kstepB, voffB);
        PG8_WAIT_V(6); PG8_BAR;
    }
    for (;;) {
        const bool has_next = S.next(ui + 1, nxt);
        const char* nA = has_next ? (const char*)g.A + (size_t)nxt.pm * tstep + (size_t)nxt.k0 * kstep : cA; const char* nB = has_next ? (const char*)g.Bt + (size_t)nxt.pn * tstep + (size_t)nxt.k0 * kstepB : cB;
        const int nt = cur.nt;
        for (int t = 0; t < nt; t += 2) {
            const bool last = (t == nt - 2);
            const char* a1 = cA + (size_t)(t + 1) * kstep;
            const char* a2 = last ? nA : cA + (size_t)(t + 2) * kstep; const char* b2 = last ? nB : cB + (size_t)(t + 2) * kstepB;
            const char* a3 = a2 + kstep; const char* b3 = b2 + kstepB;
            if (last && has_next) S.a_ready(nxt);
            if constexpr (SP2) {
            PG8_LDB(B0, 0, 0); PG8_LDB(B1, 0, 1); PG8_SCHED; PG8_LDA(At, 0, 0); PG8_STAGE(PG8_SA(1, 1), a1 + hstep, voffA);
            PG8_WAIT_V(8); PG8_WAIT_L(0); PG8_BAR; PG8_MMA(0, 0, At, B0); PG8_MMA(0, 1, At, B1); PG8_BAR; PG8_SCHED;
            PG8_LDA(At, 0, 1); PG8_STAGE(PG8_SB(0, 0), b2, voffB); PG8_STAGE(PG8_SB(0, 1), b2 + hstep, voffB); PG8_STAGE(PG8_SA(0, 0), a2, voffA);
            PG8_WAIT_V(8); PG8_WAIT_L(0); PG8_BAR; PG8_MMA(1, 0, At, B0); PG8_MMA(1, 1, At, B1); PG8_BAR; PG8_SCHED;
            PG8_LDB(B0, 1, 0); PG8_LDB(B1, 1, 1); PG8_SCHED; PG8_LDA(At, 1, 0); PG8_STAGE(PG8_SA(0, 1), a2 + hstep, voffA);
            PG8_WAIT_V(8); PG8_WAIT_L(0); PG8_BAR; PG8_MMA(0, 0, At, B0); PG8_MMA(0, 1, At, B1); PG8_BAR; PG8_SCHED;
            PG8_LDA(At, 1, 1); PG8_STAGE(PG8_SB(1, 0), b3, voffB); PG8_STAGE(PG8_SB(1, 1), b3 + hstep, voffB); PG8_STAGE(PG8_SA(1, 0), a3, voffA);
            PG8_WAIT_V(8); PG8_WAIT_L(0); PG8_BAR; PG8_MMA(1, 0, At, B0); PG8_MMA(1, 1, At, B1); PG8_BAR; PG8_SCHED;
            } else {
            PG8_LDB(B0, 0, 0); PG8_SCHED; PG8_LDA(At, 0, 0); PG8_STAGE(PG8_SA(1, 1), a1 + hstep, voffA);
            PG8_WAIT_L(8); PG8_BAR; PG8_WAIT_L(0); PG8_MMA(0, 0, At, B0); PG8_BAR; PG8_SCHED;
            PG8_LDB(B1, 0, 1); PG8_STAGE(PG8_SB(0, 0), b2, voffB);
            PG8_BAR; PG8_WAIT_L(0); PG8_MMA(0, 1, At, B1); PG8_BAR;
            PG8_LDA(At, 0, 1); PG8_STAGE(PG8_SA(0, 0), a2, voffA);
            PG8_BAR; PG8_WAIT_L(0); PG8_MMA(1, 0, At, B0); PG8_BAR; PG8_SCHED;
            PG8_STAGE(PG8_SB(0, 1), b2 + hstep, voffB);
            PG8_WAIT_V(6); PG8_BAR; PG8_MMA(1, 1, At, B1); PG8_BAR;
            PG8_LDB(B0, 1, 0); PG8_SCHED; PG8_LDA(At, 1, 0); PG8_STAGE(PG8_SA(0, 1), a2 + hstep, voffA);
            PG8_WAIT_L(8); PG8_BAR; PG8_WAIT_L(0); PG8_MMA(0, 0, At, B0); PG8_BAR; PG8_SCHED;
            PG8_LDB(B1, 1, 1); PG8_STAGE(PG8_SB(1, 0), b3, voffB);
            PG8_BAR; PG8_WAIT_L(0); PG8_MMA(0, 1, At, B1); PG8_BAR;
            PG8_LDA(At, 1, 1); PG8_STAGE(PG8_SA(1, 0), a3, voffA);
            PG8_BAR; PG8_WAIT_L(0); PG8_MMA(1, 0, At, B0); PG8_BAR; PG8_SCHED;
            PG8_STAGE(PG8_SB(1, 1), b3 + hstep, voffB);
            PG8_WAIT_V(6); PG8_BAR; PG8_MMA(1, 1, At, B1); PG8_BAR;
            }
        }
        if constexpr (ALIGN_EPI) { if (wr == 0) PG8_BAR; }
        if constexpr (!Epi::AFTER_DRAIN) { E(acc, cur, wr, wc, fr, fq); S.done(cur); }
        if (!has_next) break;
#pragma unroll
        for (int a = 0; a < 2; ++a)
#pragma unroll
            for (int b = 0; b < 2; ++b)
#pragma unroll
                for (int m = 0; m < 4; ++m)
#pragma unroll
                    for (int n = 0; n < 2; ++n) acc[a][b][m][n] = (f32x4){0.f, 0.f, 0.f, 0.f};
        cur = nxt; cA = nA; cB = nB; ++ui;
        if constexpr (ALIGN_EPI) { if (wr == 1) PG8_BAR; }
    }
    PG8_WAIT_V(0);
    if constexpr (!ALIGN_EPI) { if (wr == 0) PG8_BAR; }
    PG8_BAR;
    if constexpr (Epi::AFTER_DRAIN) { E.fused(acc, cur, wr, wc, fr, fq, lds, wid, lane); S.done(cur); }
#undef PG8_SA
#undef PG8_SB
#undef PG8_STAGE
#undef PG8_LDA
#undef PG8_LDB
#undef PG8_MMA
#undef PG8_WAIT_V
#undef PG8_WAIT_L
#undef PG8_BAR
#undef PG8_SCHED
}
}
#define GAS __attribute__((address_space(1)))
#define LAS __attribute__((address_space(3)))
typedef unsigned short bf16;
typedef unsigned v4u __attribute__((ext_vector_type(4)));
typedef float f32x4 __attribute__((ext_vector_type(4)));
typedef short bf16x8 __attribute__((ext_vector_type(8)));
typedef GAS unsigned gu32;
typedef GAS unsigned long long gu64;
#define RLX_AGENT __ATOMIC_RELAXED, __HIP_MEMORY_SCOPE_AGENT
#define LDS_WAIT() asm volatile("s_waitcnt lgkmcnt(0)" ::: "memory")
#define VM_WAIT() asm volatile("s_waitcnt vmcnt(0)" ::: "memory")
__device__ __forceinline__ unsigned long long rt() { return __builtin_amdgcn_s_memrealtime(); }
__device__ __forceinline__ unsigned f2bf(float f) { unsigned u = __builtin_bit_cast(unsigned, f); return (u + 0x7fffu + ((u >> 16) & 1u)) >> 16; }
__device__ __forceinline__ unsigned pk2(float lo, float hi) { return f2bf(lo) | (f2bf(hi) << 16); }
#define XB_TMO      128
#define XB_XCNT(j)  (256  + 64 * (j))
#define XB_XSUB(j)  (1280 + 64 * (j))
#define XB_XGEN(j)  (2304 + 64 * (j))
#define XB_TOP      3328
#define XB_TOPGEN   3392
#define XCD_BAR_WORDS 3456
#define XB_SPIN_CAP (1u << 18)

__device__ __forceinline__ unsigned xb_ld(unsigned* p)              { return __hip_atomic_load(p, __ATOMIC_RELAXED, __HIP_MEMORY_SCOPE_AGENT); }
__device__ __forceinline__ unsigned xb_add(unsigned* p, unsigned v) { return __hip_atomic_fetch_add(p, v, __ATOMIC_RELAXED, __HIP_MEMORY_SCOPE_AGENT); }
__device__ __forceinline__ unsigned xb_xcc_id() { return (unsigned)__builtin_amdgcn_s_getreg((3 << 11) | 20) & 0xFu; }
#define XB_SPIN(cond, bar) do { unsigned _sp = 0; while (cond) { __builtin_amdgcn_s_sleep(1); \
    if ((++_sp & 255u) == 0u) { if (xb_ld(&(bar)[XB_TMO])) break; if (_sp > XB_SPIN_CAP) { atomicAdd(&(bar)[XB_TMO], 1u); break; } } } } while (0)

struct XcdBarrier {
    unsigned* bar; unsigned x;
    volatile LAS unsigned* st;
};

__device__ __forceinline__ XcdBarrier xcd_barrier_post(unsigned* bar, volatile LAS unsigned* st) {
    XcdBarrier b; b.bar = bar; b.x = xb_xcc_id(); b.st = st;
    if (threadIdx.x == 0) (void)xb_add(&bar[XB_XCNT(b.x)], 1u);
    return b;
}
__device__ __forceinline__ void xcd_barrier_complete(unsigned* bar, unsigned x, unsigned& nloc, unsigned& nx) {
    const unsigned G = gridDim.x * gridDim.y * gridDim.z;
    unsigned sum, cnt, mine, sp = 0u;
    for (;;) {
        sum = 0u; cnt = 0u; mine = 0u;
#pragma unroll
        for (unsigned j = 0; j < 16; ++j) { const unsigned c = xb_ld(&bar[XB_XCNT(j)]); sum += c; cnt += (c > 0u) ? 1u : 0u; mine = (j == x) ? c : mine; }
        if (sum == G) break;
        __builtin_amdgcn_s_sleep(1);
        if ((++sp & 255u) == 0u) { if (xb_ld(&bar[XB_TMO])) break; if (sp > XB_SPIN_CAP) { atomicAdd(&bar[XB_TMO], 1u); break; } }
    }
    nloc = mine > 0u ? mine : 1u; nx = cnt > 0u ? cnt : 1u;
}

__device__ __forceinline__ void xcd_barrier(const XcdBarrier& b) {
    asm volatile("s_waitcnt vmcnt(0)" ::: "memory");
    __syncthreads();
    if (threadIdx.x == 0) {
        unsigned* bar = b.bar;
        __builtin_amdgcn_s_waitcnt(0);
        unsigned nloc = b.st[0], nx = b.st[1];
        if (nloc == 0u) { xcd_barrier_complete(bar, b.x, nloc, nx); b.st[0] = nloc; b.st[1] = nx; }
        const unsigned old = xb_add(&bar[XB_XSUB(b.x)], 1u);
        const unsigned gen = old / nloc;
        if (old + 1u == (gen + 1u) * nloc) {
            __builtin_amdgcn_fence(__ATOMIC_RELEASE, "agent");
            asm volatile("s_waitcnt vmcnt(0)" ::: "memory");
            const unsigned og = xb_add(&bar[XB_TOP], 1u);
            const unsigned tg = og / nx;
            if (og + 1u == (tg + 1u) * nx) xb_add(&bar[XB_TOPGEN], 1u);
            else XB_SPIN(xb_ld(&bar[XB_TOPGEN]) == tg, bar);
            __builtin_amdgcn_fence(__ATOMIC_ACQUIRE, "agent");
            xb_add(&bar[XB_XGEN(b.x)], 1u);
            asm volatile("s_waitcnt vmcnt(0)" ::: "memory");
        } else {
            XB_SPIN(xb_ld(&bar[XB_XGEN(b.x)]) == gen, bar);
            __builtin_amdgcn_fence(__ATOMIC_ACQUIRE, "agent");
            asm volatile("s_waitcnt vmcnt(0)" ::: "memory");
        }
    }
    __syncthreads();
}
constexpr int NWAVES = 8;
constexpr int DM = 2048, NBATCH = 4, SEQ = 2048, CTXL = 256, DFF = 5632, CDIM = 1024, CONVK = 31, SDIM = 1024, NGRP = 64, NST = 64, NIN = 7168, MODW = 9 * DM;
constexpr int ML = NBATCH * SEQ, MC = NBATCH * CTXL, MT = ML + MC;
constexpr float EPS = 1e-6f;
#ifndef MK_PER_PHASE
#define MK_PER_PHASE 0
#endif

constexpr size_t MiB = 1u << 20;
constexpr size_t WS_CTL = 0, WS_MOD = 1 * MiB, ZERO_BYTES = 2 * MiB;
constexpr size_t WS_LAM = 2 * MiB, WS_LAMT = WS_LAM + 128 * 1024, WS_BOP = 3 * MiB, WS_COP = 4 * MiB;
constexpr size_t WS_W = 6 * MiB, W_LAYER = 180 * MiB;
constexpr size_t WO_UP1 = 0, WO_DN1 = 44 * MiB, WO_IN = 66 * MiB, WO_CO = 94 * MiB, WO_GLU = 98 * MiB, WO_OUT = 106 * MiB, WO_UP2 = 114 * MiB, WO_DN2 = 158 * MiB;
constexpr size_t WS_X = 366 * MiB, WS_H = 438 * MiB, WS_ACT = 474 * MiB, WS_UCONV = 573 * MiB, WS_SSMIN = 591 * MiB, WS_GATES = 609 * MiB, WS_CONVACT = 681 * MiB, WS_SSMACT = 699 * MiB;
constexpr size_t WS_YF = 717 * MiB, WS_YB = 753 * MiB, WS_T1 = 789 * MiB, WS_MIX = 825 * MiB, WS_E = 861 * MiB, WS_SLAB = 864 * MiB, WS_END = 928 * MiB;
constexpr int CW_TMO = 0, CW_BAR = 4096;
constexpr int RING_OFF = 0, RING_BYTES = 131072, LDSCTL_OFF = RING_BYTES, MISC_OFF = LDSCTL_OFF + 320, LDS_BYTES = 147456;

#ifndef REPMASK
#define REPMASK 0u
#endif
#ifndef REPN
#define REPN 2
#endif
#define REP(s) for (int rep_ = 0; rep_ < ((((REPMASK) >> (s)) & 1u) ? REPN : 1); ++rep_)
typedef float f32x2 __attribute__((ext_vector_type(2)));
typedef float f32x16 __attribute__((ext_vector_type(16)));
typedef unsigned u32x2 __attribute__((ext_vector_type(2)));
__device__ __forceinline__ float wave_sum(float v) {
#pragma unroll
    for (int o = 1; o < 64; o <<= 1) v += __shfl_xor(v, o);
    return v;
}
__device__ __forceinline__ unsigned pkbf(float lo, float hi) { return pg8::cvt_pk_bf16(lo, hi); }
__device__ __forceinline__ float bf_lo(unsigned w) { return __uint_as_float(w << 16); }
__device__ __forceinline__ float bf_hi(unsigned w) { return __uint_as_float(w & 0xffff0000u); }
__device__ __forceinline__ float gelu_tanh(float x) {
    const float z = 0.7978845608028654f * (x + 0.044715f * x * x * x);
    const float e = __expf(2.0f * z);
    const float t = 1.0f - 2.0f * __builtin_amdgcn_rcpf(e + 1.0f);
    return 0.5f * x * (1.0f + t);
}
__device__ __forceinline__ float sigm(float x) { return __builtin_amdgcn_rcpf(1.0f + __expf(-x)); }

struct Args { const float* in[32]; float* out; unsigned char* ws; int ph_lo, ph_hi; };

struct Frame {
    LAS unsigned char* lds;
    int tid, lane, wave, vcu, G;
    unsigned char* ws;
};

__device__ __forceinline__ Frame refresh(const Frame& F0) { Frame F = F0; int t = threadIdx.x; asm volatile("" : "+v"(t)); F.tid = t; F.lane = t & 63; F.wave = __builtin_amdgcn_readfirstlane(t >> 6); return F; }
__device__ __forceinline__ void transpose_item(const float* W, int K, int N, bf16* WT, int k0, int n0, int drow0, LAS float* scr, int lane) {
#pragma unroll 8
    for (int i = 0; i < 32; ++i) { const int kk = 2 * i + (lane >> 5); scr[kk * 33 + (lane & 31)] = W[(size_t)(k0 + kk) * N + n0 + (lane & 31)]; }
    LDS_WAIT(); asm volatile("" ::: "memory");
    const int c = lane & 7;
#pragma unroll
    for (int j = 0; j < 4; ++j) { const int n = (lane >> 3) + 8 * j; const LAS float* s = scr + (8 * c) * 33 + n;
        v4u o; o.x = pkbf(s[0 * 33], s[1 * 33]); o.y = pkbf(s[2 * 33], s[3 * 33]); o.z = pkbf(s[4 * 33], s[5 * 33]); o.w = pkbf(s[6 * 33], s[7 * 33]);
        const int dr = drow0 + n;
        *(GAS v4u*)(WT + ((size_t)(dr >> 7) * (K >> 6) + (k0 >> 6)) * 8192 + (size_t)(dr & 127) * 64 + 8 * c) = o; }
    LDS_WAIT(); asm volatile("" ::: "memory");
}
__device__ __forceinline__ int glu_row(int n, int HC) { const int half = n >= HC ? 1 : 0, j = n - half * HC; return (j >> 7) * 256 + half * 128 + (j & 127); }

__device__ __forceinline__ void phase_prologue(const Frame& F0, const Args& args) {
    const Frame F = refresh(F0);
    const int gw = F.vcu * NWAVES + F.wave, NGW = F.G * NWAVES;
    unsigned char* ws = F.ws;
    {
        LAS float* sc = (LAS float*)(F.lds + RING_OFF);
        const float* c = args.in[1]; const float* cc = args.in[3];
        for (int i = F.tid; i < 5 * DM; i += NWAVES * 64) { const float v = i < 4 * DM ? c[i] : cc[i - 4 * DM]; sc[i] = v * sigm(v); }
        __syncthreads();
        const float* ada_w = args.in[4]; const float* ada_b = args.in[5];
        float* MOD = (float*)(ws + WS_MOD);
        REP(15) for (int it = gw; it < 288 * 8; it += NGW) {
            const float repz = rep_ ? 0.f : 1.f;
            const int cb = it >> 3, kc = it & 7, l = cb / 144, n0 = (cb % 144) * 128 + 2 * F.lane;
            const float* wp = ada_w + ((size_t)l * DM + (size_t)kc * 256) * MODW + n0;
            f32x2 a0 = {0.f, 0.f}, a1 = a0, a2 = a0, a3 = a0, a4 = a0;
            const LAS float* s = sc + kc * 256;
#pragma unroll 8
            for (int k = 0; k < 256; ++k) { const f32x2 w = *(const f32x2*)(wp + (size_t)k * MODW);
                a0 += w * s[k]; a1 += w * s[DM + k]; a2 += w * s[2 * DM + k]; a3 += w * s[3 * DM + k]; a4 += w * s[4 * DM + k]; }
            if (kc == 0) { const f32x2 b = *(const f32x2*)(ada_b + (size_t)l * MODW + n0); a0 += b; a1 += b; a2 += b; a3 += b; a4 += b; }
            float* mp = MOD + (size_t)l * 5 * MODW + n0;
            atomicAdd(mp + 0 * MODW, a0.x * repz); atomicAdd(mp + 0 * MODW + 1, a0.y * repz);
            atomicAdd(mp + 1 * MODW, a1.x * repz); atomicAdd(mp + 1 * MODW + 1, a1.y * repz);
            atomicAdd(mp + 2 * MODW, a2.x * repz); atomicAdd(mp + 2 * MODW + 1, a2.y * repz);
            atomicAdd(mp + 3 * MODW, a3.x * repz); atomicAdd(mp + 3 * MODW + 1, a3.y * repz);
            atomicAdd(mp + 4 * MODW, a4.x * repz); atomicAdd(mp + 4 * MODW + 1, a4.y * repz);
        }
        __syncthreads();
    }
    {
        f32x2* LAM = (f32x2*)(ws + WS_LAM); f32x2* LAMT = (f32x2*)(ws + WS_LAMT); bf16* BOP = (bf16*)(ws + WS_BOP); bf16* COP = (bf16*)(ws + WS_COP);
        const float *a_re = args.in[17], *a_im = args.in[18], *log_dt = args.in[19], *b_re = args.in[20], *b_im = args.in[21], *c_re = args.in[22], *c_im = args.in[23];
        for (int it = F.vcu * (NWAVES * 64) + F.tid; it < 2 * 2 * NGRP * NST; it += F.G * NWAVES * 64) {
            const int p = it & 63, ldg = it >> 6;
            const float ar = a_re[it], ai = a_im[it], dt = expf(log_dt[ldg]);
            const float er = expf(ar * dt), lr = er * cosf(ai * dt), li = er * sinf(ai * dt);
            LAM[it] = (f32x2){lr, li};
            float tr = lr, ti = li;
#pragma unroll
            for (int s = 0; s < 5; ++s) { const float nr = tr * tr - ti * ti, ni = 2.f * tr * ti; tr = nr; ti = ni; }
            const float t32r = tr, t32i = ti;
#pragma unroll
            for (int s = 0; s < 3; ++s) { const float nr = tr * tr - ti * ti, ni = 2.f * tr * ti; tr = nr; ti = ni; }
            LAMT[it] = (f32x2){tr * t32r - ti * t32i, tr * t32i + ti * t32r};
            const float nr = lr - 1.f, ni = li, den = 1.f / (ar * ar + ai * ai);
            const float cr = (nr * ar + ni * ai) * den, ci = (ni * ar - nr * ai) * den;
            const int jj = p & 31, hi = p >> 5;
            for (int c = 0; c < 16; ++c) {
                const float br = b_re[(size_t)it * 16 + c], bi = b_im[(size_t)it * 16 + c];
                const float vr = cr * br - ci * bi, vi = cr * bi + ci * br;
                const int lane = jj + 32 * (c >> 3), j = c & 7;
                BOP[(((size_t)ldg * 4 + (hi ? 1 : 0)) * 64 + lane) * 8 + j] = (bf16)(pkbf(vr, 0.f) & 0xffffu);
                BOP[(((size_t)ldg * 4 + (hi ? 3 : 2)) * 64 + lane) * 8 + j] = (bf16)(pkbf(vi, 0.f) & 0xffffu);
                const float cre = c_re[((size_t)ldg * 16 + c) * 64 + p], cim = c_im[((size_t)ldg * 16 + c) * 64 + p];
                const int kk = 4 * jj + (hi ? 2 : 0);
                const int ks = kk >> 5, q = (kk & 31) >> 3, j2 = kk & 7, lane2 = c + 16 * q;
                COP[(((size_t)ldg * 4 + ks) * 64 + lane2) * 8 + j2] = (bf16)(pkbf(cre, 0.f) & 0xffffu);
                COP[(((size_t)ldg * 4 + ks) * 64 + lane2) * 8 + j2 + 1] = (bf16)(pkbf(-cim, 0.f) & 0xffffu);
            }
        }
    }
    {
        LAS float* scr = (LAS float*)(F.lds + RING_OFF + F.wave * 16384);
        constexpr int I_UP = (DM / 64) * (2 * DFF / 32), I_DN = (DFF / 64) * (DM / 32), I_IN = (DM / 64) * (NIN / 32), I_CO = (CDIM / 64) * (DM / 32), I_GLU = (SDIM / 64) * (2 * DM / 32), I_OUT = (DM / 64) * (DM / 32);
        constexpr int I_LAYER = 2 * I_UP + 2 * I_DN + I_IN + I_CO + I_GLU + I_OUT;
        REP(14) for (int it = gw; it < 2 * I_LAYER; it += NGW) {
            const int l = it / I_LAYER; int r = it % I_LAYER;
            unsigned char* wl = ws + WS_W + (size_t)l * W_LAYER;
            const float* W; int K, N, kind; bf16* WT;
            if (r < I_UP) { W = args.in[7] + (size_t)l * DM * 2 * DFF; K = DM; N = 2 * DFF; kind = 1; WT = (bf16*)(wl + WO_UP1); }
            else if ((r -= I_UP) < I_DN) { W = args.in[8] + (size_t)l * DFF * DM; K = DFF; N = DM; kind = 0; WT = (bf16*)(wl + WO_DN1); }
            else if ((r -= I_DN) < I_IN) { W = args.in[10] + (size_t)l * DM * NIN; K = DM; N = NIN; kind = 2; WT = (bf16*)(wl + WO_IN); }
            else if ((r -= I_IN) < I_CO) { W = args.in[16] + (size_t)l * CDIM * DM; K = CDIM; N = DM; kind = 0; WT = (bf16*)(wl + WO_CO); }
            else if ((r -= I_CO) < I_GLU) { W = args.in[25] + (size_t)l * SDIM * 2 * DM; K = SDIM; N = 2 * DM; kind = 1; WT = (bf16*)(wl + WO_GLU); }
            else if ((r -= I_GLU) < I_OUT) { W = args.in[27] + (size_t)l * DM * DM; K = DM; N = DM; kind = 0; WT = (bf16*)(wl + WO_OUT); }
            else if ((r -= I_OUT) < I_UP) { W = args.in[29] + (size_t)l * DM * 2 * DFF; K = DM; N = 2 * DFF; kind = 1; WT = (bf16*)(wl + WO_UP2); }
            else { r -= I_UP; W = args.in[30] + (size_t)l * DFF * DM; K = DFF; N = DM; kind = 0; WT = (bf16*)(wl + WO_DN2); }
            const int nblk = N / 32, kb = r / nblk, nb = r % nblk, n0 = 32 * nb;
            int drow0 = n0;
            if (kind == 1) drow0 = glu_row(n0, N / 2);
            else if (kind == 2 && n0 < 2048) drow0 = glu_row(n0, 1024);
            transpose_item(W, K, N, WT, 64 * kb, n0, drow0, scr, F.lane);
        }
    }
}

__device__ __forceinline__ void phase_norm(const Frame& F0, const float* src_lat, const float* src_ctx, const float* gain, const float* mod, bf16* H, int nrows,
                                           const float* slab, int nslab, const float* gate, float gscale, float* Xc_out) {
    const Frame F = refresh(F0);
    const int gw = F.vcu * NWAVES + F.wave, NGW = F.G * NWAVES;
    for (int row = gw; row < nrows; row += NGW) {
        const float* xr = (row < ML ? src_lat + (size_t)row * DM : src_ctx + (size_t)(row - ML) * DM) + 4 * F.lane;
        f32x4 v[8]; float ss = 0.f;
#pragma unroll
        for (int j = 0; j < 8; ++j) v[j] = *(const f32x4*)(xr + 256 * j);
        if (row >= ML && nslab > 0) {
            const float* sp = slab + (size_t)(row - ML) * DM + 4 * F.lane; const float* gp = gate + (size_t)4 * MODW + 4 * F.lane; float* xo = Xc_out + (size_t)(row - ML) * DM + 4 * F.lane;
#pragma unroll
            for (int j = 0; j < 8; ++j) { f32x4 a = *(const f32x4*)(sp + 256 * j);
                for (int sidx = 1; sidx < nslab; ++sidx) a += *(const f32x4*)(sp + (size_t)sidx * MC * DM + 256 * j);
                v[j] += *(const f32x4*)(gp + 256 * j) * gscale * a; *(f32x4*)(xo + 256 * j) = v[j]; }
        }
#pragma unroll
        for (int j = 0; j < 8; ++j) ss += (v[j].x * v[j].x + v[j].y * v[j].y) + (v[j].z * v[j].z + v[j].w * v[j].w);
        const float rstd = 1.0f / sqrtf(wave_sum(ss) * (1.0f / DM) + EPS);
        const int mrow = row < ML ? (row >> 11) : 4;
        const float* sh = mod + (size_t)mrow * MODW + 4 * F.lane; const float* gp = gain + 4 * F.lane;
        bf16* orow = H + (size_t)row * DM + 4 * F.lane;
#pragma unroll
        for (int j = 0; j < 8; ++j) {
            const f32x4 g4 = *(const f32x4*)(gp + 256 * j), s4 = *(const f32x4*)(sh + 256 * j), c4 = *(const f32x4*)(sh + DM + 256 * j);
            const f32x4 o = (v[j] * rstd * g4) * (c4 + 1.0f) + s4;
            u32x2 w; w.x = pkbf(o.x, o.y); w.y = pkbf(o.z, o.w);
            *(u32x2*)(orow + 256 * j) = w;
        }
    }
}
__device__ __forceinline__ void phase_final(const Frame& F0, const float* X, const float* gain, float* out) {
    const Frame F = refresh(F0);
    const int gw = F.vcu * NWAVES + F.wave, NGW = F.G * NWAVES;
    for (int row = gw; row < ML; row += NGW) {
        const float* xr = X + (size_t)row * DM + 4 * F.lane;
        f32x4 v[8]; float ss = 0.f;
#pragma unroll
        for (int j = 0; j < 8; ++j) { v[j] = *(const f32x4*)(xr + 256 * j); ss += (v[j].x * v[j].x + v[j].y * v[j].y) + (v[j].z * v[j].z + v[j].w * v[j].w); }
        const float rstd = 1.0f / sqrtf(wave_sum(ss) * (1.0f / DM) + EPS);
        float* orow = out + (size_t)row * DM + 4 * F.lane; const float* gp = gain + 4 * F.lane;
#pragma unroll
        for (int j = 0; j < 8; ++j) *(f32x4*)(orow + 256 * j) = v[j] * rstd * *(const f32x4*)(gp + 256 * j);
    }
}

#define CONV_FENCE() asm volatile("" ::: "memory")
__device__ __forceinline__ void phase_conv(const Frame& F0, const bf16* UCONV, const float* dw, const float* db, const float* lng, const float* lnb, bf16* CONVACT, int nunits) {
    const Frame F = refresh(F0);
    LAS float* red = (LAS float*)(F.lds + RING_OFF);
    const int ch = 2 * F.tid;
    const f32x2 bias = *(const f32x2*)(db + ch), g2 = *(const f32x2*)(lng + ch), b2 = *(const f32x2*)(lnb + ch);
    f32x2 w[CONVK];
#pragma unroll
    for (int k = 0; k < CONVK; ++k) w[k] = *(const f32x2*)(dw + (size_t)k * CDIM + ch);
    for (int unit = F.vcu; unit < nunits; unit += F.G) {
        const bool is_ctx = unit >= 512;
        const int bb = unit >> 7, r0 = ((unit >> 4) & 7) * 4, w0 = (unit & 15) * 4;
        const int tokc = ML + (unit - 512) * 16;
        f32x2 o[16];
#pragma unroll
        for (int i = 0; i < 16; ++i) o[i] = bias;
        if (is_ctx) {
            const int base = ML + ((tokc - ML) & ~255), p0 = tokc - base;
            const bf16* up = UCONV + (size_t)base * CDIM + ch;
#pragma unroll
            for (int j = 0; j < 46; ++j) {
                const int pos = p0 - 15 + j;
                { const bool ok = pos >= 0 && pos < 256; const int pc = pos < 0 ? 0 : (pos > 255 ? 255 : pos);
                  const unsigned x = *(const unsigned*)(up + (size_t)pc * CDIM); const f32x2 v = {ok ? bf_lo(x) : 0.f, ok ? bf_hi(x) : 0.f};
#pragma unroll
                    for (int i = 0; i < 16; ++i) { const int k = j - i; if (k >= 0 && k < CONVK) o[i] += w[k] * v; } }
                if ((j & 7) == 7) CONV_FENCE();
            }
        } else if (F.tid < 256) {
#pragma unroll
            for (int rr = 0; rr < 4; ++rr) {
                const bf16* up = UCONV + (size_t)(bb * SEQ + (r0 + rr) * 64) * CDIM + ch;
#pragma unroll
                for (int j = 0; j < 34; ++j) {
                    const int pos = w0 - 15 + j;
                    { const bool ok = pos >= 0 && pos < 64; const int pc = pos < 0 ? 0 : (pos > 63 ? 63 : pos);
                      const unsigned x = *(const unsigned*)(up + (size_t)pc * CDIM); const f32x2 v = {ok ? bf_lo(x) : 0.f, ok ? bf_hi(x) : 0.f};
#pragma unroll
                        for (int cc = 0; cc < 4; ++cc) { const int k = j - cc; if (k >= 0 && k < CONVK) o[rr * 4 + cc] += w[k] * v; } }
                    if ((j & 15) == 15) CONV_FENCE();
                }
                CONV_FENCE();
            }
        } else {
#pragma unroll
            for (int cc = 0; cc < 4; ++cc) {
                const bf16* up = UCONV + (size_t)(bb * SEQ + w0 + cc) * CDIM + ch;
#pragma unroll
                for (int j = 0; j < 34; ++j) {
                    const int rpos = r0 - 15 + j;
                    { const bool ok = rpos >= 0 && rpos < 32; const int pc = rpos < 0 ? 0 : (rpos > 31 ? 31 : rpos);
                      const unsigned x = *(const unsigned*)(up + (size_t)pc * 64 * CDIM); const f32x2 v = {ok ? bf_lo(x) : 0.f, ok ? bf_hi(x) : 0.f};
#pragma unroll
                        for (int rr = 0; rr < 4; ++rr) { const int k = j - rr; if (k >= 0 && k < CONVK) o[rr * 4 + cc] += w[k] * v; } }
                    if ((j & 15) == 15) CONV_FENCE();
                }
                CONV_FENCE();
            }
        }
        float v[32];
#pragma unroll
        for (int i = 0; i < 16; ++i) { v[i] = o[i].x + o[i].y; v[16 + i] = o[i].x * o[i].x + o[i].y * o[i].y; }
#define BFLY(HALF, BIT) { const bool hi = (F.lane & BIT) != 0; _Pragma("unroll") for (int i = 0; i < HALF; ++i) { const float send = hi ? v[i] : v[HALF + i], keep = hi ? v[HALF + i] : v[i]; v[i] = keep + __shfl_xor(send, BIT); } }
        BFLY(16, 32) BFLY(8, 16) BFLY(4, 8) BFLY(2, 4) BFLY(1, 2)
#undef BFLY
        v[0] += __shfl_xor(v[0], 1);
        if ((F.lane & 1) == 0) red[F.wave * 32 + (F.lane >> 1)] = v[0];
        __syncthreads();
        if (F.tid < 32) { float t = 0.f;
#pragma unroll
            for (int wv = 0; wv < 8; ++wv) t += red[wv * 32 + F.tid];
            red[256 + F.tid] = t; }
        __syncthreads();
#pragma unroll
        for (int i = 0; i < 16; ++i) {
            const float mean = red[256 + i] * (1.0f / CDIM), var = red[256 + 16 + i] * (1.0f / CDIM) - mean * mean;
            const float rstd = 1.0f / sqrtf(fmaxf(var, 0.f) + EPS);
            const float y0 = (o[i].x - mean) * rstd * g2.x + b2.x, y1 = (o[i].y - mean) * rstd * g2.y + b2.y;
            const int tok = is_ctx ? tokc + i : bb * SEQ + (r0 + (i >> 2)) * 64 + w0 + (i & 3);
            *(unsigned*)(CONVACT + (size_t)tok * CDIM + ch) = pkbf(y0 * sigm(y0), y1 * sigm(y1));
        }
        __syncthreads();
    }
}
#undef CONV_FENCE

constexpr int SSM_CH = 288, SSM_NBLK = 18;
__device__ __forceinline__ int ssm_row(int b, int q, int d, int i) {
    const int s = q * SSM_CH + i;
    return s < CTXL ? ML + b * CTXL + (d ? CTXL - 1 - s : s) : b * SEQ + (d ? SEQ - 1 - (s - CTXL) : s - CTXL);
}
constexpr int SSM_RS = 272;
template <bool PASS2>
__device__ __forceinline__ void ssm_task(const Frame& F, int l, int d, int bp, int g, int q, const bf16* SSMIN, f32x2* E, float* Y) {
    const unsigned char* ws = F.ws;
    const int lane = F.lane, jj = lane & 31, half = lane >> 5, ldg = (l * 2 + d) * 64 + g;
    const f32x2* LAM = (const f32x2*)(ws + WS_LAM) + (size_t)ldg * 64;
    const f32x2 lam0 = LAM[jj], lam1 = LAM[32 + jj];
    pg8::bf16x8 bfr[4];
    { const pg8::bf16x8* bop = (const pg8::bf16x8*)(ws + WS_BOP) + (size_t)ldg * 4 * 64 + lane;
#pragma unroll
      for (int nb = 0; nb < 4; ++nb) bfr[nb] = bop[nb * 64]; }
    pg8::bf16x8 cfr[4];
    if (PASS2) { const pg8::bf16x8* cop = (const pg8::bf16x8*)(ws + WS_COP) + (size_t)ldg * 4 * 64 + lane;
#pragma unroll
      for (int ks = 0; ks < 4; ++ks) cfr[ks] = cop[ks * 64]; }
    float h0r = 0.f, h0i = 0.f, h1r = 0.f, h1i = 0.f;
    const int b = 2 * bp + half;
    f32x2* Eb = E + ((size_t)((d * 4 + b) * 64 + g) * 9) * 64;
    if (PASS2) {
        const f32x2* LAMT = (const f32x2*)(ws + WS_LAMT) + (size_t)ldg * 64;
        const f32x2 t0 = LAMT[jj], t1 = LAMT[32 + jj];
        f32x2 e0[7], e1[7];
#pragma unroll
        for (int qq = 0; qq < 7; ++qq) { const int qc = qq < q ? qq : 0; e0[qq] = Eb[qc * 64 + jj]; e1[qq] = Eb[qc * 64 + 32 + jj]; }
#pragma unroll
        for (int qq = 0; qq < 7; ++qq) if (qq < q) {
            const float n0r = t0.x * h0r - t0.y * h0i + e0[qq].x, n0i = t0.x * h0i + t0.y * h0r + e0[qq].y; h0r = n0r; h0i = n0i;
            const float n1r = t1.x * h1r - t1.y * h1i + e1[qq].x, n1i = t1.x * h1i + t1.y * h1r + e1[qq].y; h1r = n1r; h1i = n1i;
        }
    }
    const int iA = lane & 31, halfA = (iA >> 2) & 1, vA = 4 * (iA >> 3) + (iA & 3), bA = 2 * bp + halfA;
    const bf16* ucol = SSMIN + g * 16 + 8 * (lane >> 5);
    LAS unsigned char* img = F.lds + RING_OFF + F.wave * (32 * SSM_RS);
    pg8::bf16x8 a_nxt = *(const pg8::bf16x8*)(ucol + (size_t)ssm_row(bA, q, d, vA) * SDIM);
    for (int blk = 0; blk < SSM_NBLK; ++blk) {
        const pg8::bf16x8 a = a_nxt;
        if (blk + 1 < SSM_NBLK) a_nxt = *(const pg8::bf16x8*)(ucol + (size_t)ssm_row(bA, q, d, (blk + 1) * 16 + vA) * SDIM);
        f32x16 acc[4];
#pragma unroll
        for (int nb = 0; nb < 4; ++nb) { f32x16 z;
#pragma unroll
            for (int e = 0; e < 16; ++e) z[e] = 0.f;
            acc[nb] = __builtin_amdgcn_mfma_f32_32x32x16_bf16(a, bfr[nb], z, 0, 0, 0); }
#pragma unroll
        for (int v = 0; v < 16; ++v) {
            const float n0r = lam0.x * h0r - lam0.y * h0i + acc[0][v], n0i = lam0.x * h0i + lam0.y * h0r + acc[2][v]; h0r = n0r; h0i = n0i;
            const float n1r = lam1.x * h1r - lam1.y * h1i + acc[1][v], n1i = lam1.x * h1i + lam1.y * h1r + acc[3][v]; h1r = n1r; h1i = n1i;
            if (PASS2) { u32x2 w; w.x = pkbf(h0r, h0i); w.y = pkbf(h1r, h1i); *(LAS u32x2*)(img + (half * 16 + v) * SSM_RS + 8 * jj) = w; }
        }
        if (PASS2) {
            LDS_WAIT(); asm volatile("" ::: "memory");
            pg8::f32x4 yacc[2];
#pragma unroll
            for (int tb = 0; tb < 2; ++tb) { yacc[tb] = (pg8::f32x4){0.f, 0.f, 0.f, 0.f};
#pragma unroll
                for (int ks = 0; ks < 4; ++ks) { const pg8::bf16x8 af = *(const LAS pg8::bf16x8*)(img + (tb * 16 + (lane & 15)) * SSM_RS + (32 * ks + 8 * (lane >> 4)) * 2);
                    yacc[tb] = __builtin_amdgcn_mfma_f32_16x16x32_bf16(cfr[ks], af, yacc[tb], 0, 0, 0); } }
            LDS_WAIT(); asm volatile("" ::: "memory");
            const int tk = lane & 15, q4 = lane >> 4;
#pragma unroll
            for (int tb = 0; tb < 2; ++tb) *(pg8::f32x4*)(Y + (size_t)ssm_row(2 * bp + tb, q, d, blk * 16 + tk) * SDIM + g * 16 + 4 * q4) = yacc[tb];
        }
    }
    if (!PASS2) { Eb[q * 64 + jj] = (f32x2){h0r, h0i}; Eb[q * 64 + 32 + jj] = (f32x2){h1r, h1i}; }
}
template <bool PASS2>
__device__ __forceinline__ void phase_ssm(const Frame& F0, int l, const bf16* SSMIN, f32x2* E, float* YF, float* YB, int q_lo, int q_hi) {
    const Frame F = refresh(F0);
    const int gw = F.vcu * NWAVES + F.wave, NGW = F.G * NWAVES, nq = q_hi - q_lo;
    for (int t = gw; t < 256 * nq; t += NGW) {
        const int d = t & 1, bp = (t >> 1) & 1, g = (t >> 2) & 63, q = q_lo + (t >> 8);
        ssm_task<PASS2>(F, l, d, bp, g, q, SSMIN, E, d ? YB : YF);
    }
}
__device__ __forceinline__ void phase_ssm_post(const Frame& F0, const float* YF, const float* YB, const bf16* SSMIN, const float* ssm_d, bf16* SSMACT, int nrows) {
    const Frame F = refresh(F0);
    const size_t n8 = (size_t)nrows * SDIM / 8;
    for (size_t i = (size_t)F.vcu * (NWAVES * 64) + F.tid; i < n8; i += (size_t)F.G * NWAVES * 64) {
        const size_t e = i * 8; const int c = (int)(e & (SDIM - 1));
        const pg8::f32x4 f0 = *(const pg8::f32x4*)(YF + e), f1 = *(const pg8::f32x4*)(YF + e + 4), b0 = *(const pg8::f32x4*)(YB + e), b1 = *(const pg8::f32x4*)(YB + e + 4);
        const pg8::f32x4 d0 = *(const pg8::f32x4*)(ssm_d + c), d1 = *(const pg8::f32x4*)(ssm_d + c + 4);
        const pg8::u32x4 uw = *(const pg8::u32x4*)(SSMIN + e);
        const pg8::f32x4 y0 = f0 + b0 + d0 * pg8::bf4_lo(uw, 0), y1 = f1 + b1 + d1 * pg8::bf4_lo(uw, 1);
        pg8::u32x4 w; w.x = pkbf(gelu_tanh(y0[0]), gelu_tanh(y0[1])); w.y = pkbf(gelu_tanh(y0[2]), gelu_tanh(y0[3])); w.z = pkbf(gelu_tanh(y1[0]), gelu_tanh(y1[1])); w.w = pkbf(gelu_tanh(y1[2]), gelu_tanh(y1[3]));
        *(pg8::u32x4*)(SSMACT + e) = w;
    }
}

constexpr int PH_PER_LAYER = 14, PH_FINAL = 1 + 2 * PH_PER_LAYER, NPHASES = PH_FINAL + 1;
__global__ void __launch_bounds__(NWAVES * 64, 2) fwd_kernel(Args args) {
    extern __shared__ __attribute__((aligned(16))) unsigned char lds[];
    Frame F;
    F.lds = (LAS unsigned char*)lds;
    F.tid = threadIdx.x; F.lane = F.tid & 63; F.wave = __builtin_amdgcn_readfirstlane(F.tid >> 6);
    F.G = gridDim.x; { const int bx = blockIdx.x; F.vcu = (F.G % 8 == 0) ? (bx % 8) * (F.G / 8) + bx / 8 : bx; }
    F.ws = args.ws;
    unsigned char* ws = args.ws;
    gu32* ctl = (gu32*)(ws + WS_CTL);
    volatile LAS unsigned* MISC = (volatile LAS unsigned*)(F.lds + MISC_OFF);
    for (int u = F.tid; u < (LDS_BYTES - LDSCTL_OFF) / 4; u += NWAVES * 64) ((LAS unsigned*)(F.lds + LDSCTL_OFF))[u] = 0u;
    __syncthreads();
    const int lo = args.ph_lo, hi = args.ph_hi;
    XcdBarrier bar; bar.bar = (unsigned*)(ctl + CW_BAR); bar.x = 0; bar.st = nullptr;
    if (hi - lo > 1) bar = xcd_barrier_post((unsigned*)(ctl + CW_BAR), MISC + 8);
#ifndef PHMASK
#define PHMASK 0xFFFFFFFFu
#endif
#define PHON(s) (((PHMASK) >> (s)) & 1u)
#define IN(k) (lo <= (k) && (k) < hi)
#define SEAM(k) do { if (IN((k) + 1)) xcd_barrier(bar); } while (0)

    float* MOD = (float*)(ws + WS_MOD);
    float* X = (float*)(ws + WS_X); bf16* H = (bf16*)(ws + WS_H); bf16* ACT = (bf16*)(ws + WS_ACT);
    bf16* UCONV = (bf16*)(ws + WS_UCONV); bf16* SSMIN = (bf16*)(ws + WS_SSMIN); bf16* GATES = (bf16*)(ws + WS_GATES);
    bf16* CONVACT = (bf16*)(ws + WS_CONVACT); bf16* SSMACT = (bf16*)(ws + WS_SSMACT);
    float* YF = (float*)(ws + WS_YF); float* YB = (float*)(ws + WS_YB); bf16* T1 = (bf16*)(ws + WS_T1); bf16* MIX = (bf16*)(ws + WS_MIX); f32x2* E = (f32x2*)(ws + WS_E); float* SLAB = (float*)(ws + WS_SLAB);

    float* DUMMY = (float*)(ws + WS_END);
    if (PHON(14) && IN(0)) { phase_prologue(F, args); SEAM(0); }

    for (int l = 0; l < 2; ++l) {
        const int pb = 1 + PH_PER_LAYER * l;
        const bool last = (l == 1);
        unsigned char* wl = ws + WS_W + (size_t)l * W_LAYER;
        const float* modl = MOD + (size_t)l * 5 * MODW;
        const float* x_lat = l == 0 ? args.in[0] : X; const float* x_ctx = l == 0 ? args.in[2] : X + (size_t)ML * DM;
        float* Xc = X + (size_t)ML * DM;
        if (PHON(0) && IN(pb + 0)) REP(0) { phase_norm(F, x_lat, x_ctx, args.in[6] + (size_t)l * DM, modl + 0 * DM, H, MT, SLAB, l == 0 ? 0 : 4, MOD + 8 * DM, 0.5f, Xc); SEAM(pb + 0); }
        if (PHON(1) && IN(pb + 1)) REP(1) { pg8::Gemm g{H, (const bf16*)(wl + WO_UP1), MT, 2 * DFF, DM, 0}; pg8::Order S; S.init(MT, 2 * DFF, g.K, F.G, (int)blockIdx.x);
            pg8::EpiSwiGLU Ep{ACT, DFF}; pg8::gemm_phase<pg8::EpiSwiGLU, pg8::Order, true, true>(F.lds + RING_OFF, g, S, Ep); SEAM(pb + 1); }
        if (PHON(2) && IN(pb + 2)) REP(2) { pg8::Gemm g{ACT, (const bf16*)(wl + WO_DN1), MT, DM, DFF, 1}; pg8::Order S; S.init(ML, DM, g.K, F.G, (int)blockIdx.x); S.extra(32, 32, 0, 8, 4);
            pg8::EpiResid Ep{x_lat, x_ctx, rep_ ? DUMMY : X, modl + 2 * DM, 0.5f, rep_ ? DUMMY : SLAB, DFF / 64}; pg8::gemm_phase<pg8::EpiResid, pg8::Order, true, true>(F.lds + RING_OFF, g, S, Ep); SEAM(pb + 2); }
        if (PHON(3) && IN(pb + 3)) REP(3) { phase_norm(F, X, x_ctx, args.in[9] + (size_t)l * DM, modl + 3 * DM, H, MT, SLAB, 4, modl + 2 * DM, 0.5f, Xc); SEAM(pb + 3); }
        if (PHON(4) && IN(pb + 4)) REP(4) { pg8::Gemm g{H, (const bf16*)(wl + WO_IN), MT, NIN, DM, 0}; pg8::Order S;
            if (!last) S.init(MT, NIN, g.K, F.G, (int)blockIdx.x); else { S.init(ML, NIN, g.K, F.G, (int)blockIdx.x); S.extra(16, 32, 8, 4, 1); }
            pg8::EpiProj Ep{UCONV, SSMIN, GATES, args.in[11] + (size_t)l * NIN}; pg8::gemm_phase<pg8::EpiProj, pg8::Order, true, true>(F.lds + RING_OFF, g, S, Ep); SEAM(pb + 4); }
        if (PHON(5) && IN(pb + 5)) REP(5) {
            phase_conv(F, UCONV, args.in[12] + (size_t)l * CONVK * CDIM, args.in[13] + (size_t)l * CDIM, args.in[14] + (size_t)l * CDIM, args.in[15] + (size_t)l * CDIM, CONVACT, last ? 512 : 576);
            phase_ssm<false>(F, l, SSMIN, E, YF, YB, 0, 7);
            SEAM(pb + 5); }
        if (PHON(6) && IN(pb + 6)) REP(6) { phase_ssm<true>(F, l, SSMIN, E, YF, YB, 0, 8); SEAM(pb + 6); }
        if (PHON(7) && IN(pb + 7)) REP(7) { phase_ssm_post(F, YF, YB, SSMIN, args.in[24] + (size_t)l * SDIM, SSMACT, last ? ML : MT); SEAM(pb + 7); }
        const int Mx = last ? ML : MT;
        if (PHON(8) && IN(pb + 8)) REP(8) { pg8::Gemm g{SSMACT, (const bf16*)(wl + WO_GLU), Mx, 2 * DM, SDIM, 0}; pg8::Order S; S.init(Mx, 2 * DM, g.K, F.G, (int)blockIdx.x);
            pg8::EpiGluGate Ep{T1, GATES, args.in[26] + (size_t)l * 2 * DM}; pg8::gemm_phase<pg8::EpiGluGate, pg8::Order, true, true>(F.lds + RING_OFF, g, S, Ep); SEAM(pb + 8); }
        if (PHON(9) && IN(pb + 9)) REP(9) { pg8::Gemm g{CONVACT, (const bf16*)(wl + WO_CO), Mx, DM, CDIM, 0}; pg8::Order S; S.init(Mx, DM, g.K, F.G, (int)blockIdx.x);
            pg8::EpiConvMix Ep{MIX, GATES, T1}; pg8::gemm_phase<pg8::EpiConvMix, pg8::Order, true, true>(F.lds + RING_OFF, g, S, Ep); SEAM(pb + 9); }
        if (PHON(10) && IN(pb + 10)) REP(10) { pg8::Gemm g{MIX, (const bf16*)(wl + WO_OUT), Mx, DM, DM, 1}; pg8::Order S; S.init(ML, DM, g.K, F.G, (int)blockIdx.x); if (!last) S.extra(32, 32, 0, 8, 8);
            pg8::EpiResid Ep{X, Xc, rep_ ? DUMMY : X, modl + 5 * DM, 1.0f, rep_ ? DUMMY : SLAB, DM / 64}; pg8::gemm_phase<pg8::EpiResid, pg8::Order, true, true>(F.lds + RING_OFF, g, S, Ep); SEAM(pb + 10); }
        if (PHON(11) && IN(pb + 11)) REP(11) { phase_norm(F, X, Xc, args.in[28] + (size_t)l * DM, modl + 6 * DM, H, Mx, SLAB, last ? 0 : 8, modl + 5 * DM, 1.0f, Xc); SEAM(pb + 11); }
        if (PHON(12) && IN(pb + 12)) REP(12) { pg8::Gemm g{H, (const bf16*)(wl + WO_UP2), Mx, 2 * DFF, DM, 0}; pg8::Order S; S.init(Mx, 2 * DFF, g.K, F.G, (int)blockIdx.x);
            pg8::EpiSwiGLU Ep{ACT, DFF}; pg8::gemm_phase<pg8::EpiSwiGLU, pg8::Order, true, true>(F.lds + RING_OFF, g, S, Ep); SEAM(pb + 12); }
        if (PHON(13) && IN(pb + 13)) REP(13) { pg8::Gemm g{ACT, (const bf16*)(wl + WO_DN2), Mx, DM, DFF, 1}; pg8::Order S; S.init(ML, DM, g.K, F.G, (int)blockIdx.x); if (!last) S.extra(32, 32, 0, 8, 4);
            pg8::EpiResid Ep{X, Xc, rep_ ? DUMMY : X, modl + 8 * DM, 0.5f, rep_ ? DUMMY : SLAB, DFF / 64}; pg8::gemm_phase<pg8::EpiResid, pg8::Order, true, true>(F.lds + RING_OFF, g, S, Ep); SEAM(pb + 13); }
    }
    if (PHON(15) && IN(PH_FINAL)) phase_final(F, X, args.in[31], args.out);
#undef IN
#undef SEAM
}

extern "C" void kernel_launch(void* const* d_in, const int* in_sizes, int n_in, void* d_out, int out_size, void* d_ws, size_t ws_size, hipStream_t stream) {
    static int grid = 0;
    if (grid == 0) {
        if (n_in != 32 || in_sizes[0] != ML * DM || out_size != ML * DM || ws_size < WS_END) { fprintf(stderr, "kernel_launch: unexpected shapes (n_in %d, in0 %d, out %d, ws %zu); nothing launched\n", n_in, n_in > 0 ? in_sizes[0] : -1, out_size, ws_size); grid = -1; return; }
        int dev = 0, cus = 0, per_cu = 0;
        if (hipGetDevice(&dev) != hipSuccess || hipDeviceGetAttribute(&cus, hipDeviceAttributeMultiprocessorCount, dev) != hipSuccess) { grid = -1; return; }
        if (hipFuncSetAttribute((const void*)fwd_kernel, hipFuncAttributeMaxDynamicSharedMemorySize, LDS_BYTES) != hipSuccess) { fprintf(stderr, "kernel_launch: hipFuncSetAttribute failed\n"); grid = -1; return; }
        if (hipOccupancyMaxActiveBlocksPerMultiprocessor(&per_cu, (const void*)fwd_kernel, NWAVES * 64, LDS_BYTES) != hipSuccess || per_cu < 1) fprintf(stderr, "kernel_launch: occupancy query reports %d blocks per CU\n", per_cu);
        (void)hipGetLastError();
        grid = cus;
    }
    if (grid < 0) return;
    if (hipMemsetAsync((char*)d_ws + WS_CTL, 0, ZERO_BYTES, stream) != hipSuccess) { fprintf(stderr, "kernel_launch: memset failed\n"); return; }
    Args a{};
    for (int i = 0; i < 32; ++i) a.in[i] = (const float*)d_in[i];
    a.out = (float*)d_out; a.ws = (unsigned char*)d_ws;
#if MK_PER_PHASE
    for (int p = 0; p < NPHASES; ++p) { a.ph_lo = p; a.ph_hi = p + 1; hipLaunchKernelGGL(fwd_kernel, dim3(grid), dim3(NWAVES * 64), LDS_BYTES, stream, a); }
#else
    a.ph_lo = 0; a.ph_hi = NPHASES; hipLaunchKernelGGL(fwd_kernel, dim3(grid), dim3(NWAVES * 64), LDS_BYTES, stream, a);
#endif
    const hipError_t le = hipPeekAtLastError();
    if (le != hipSuccess) fprintf(stderr, "kernel_launch: launch failed: %s\n", hipGetErrorName(le));
}
```

```cpp
#include <hip/hip_runtime.h>
#include <cstdio>
#include <cstdint>
namespace pg8 {
#define PG8_LAS __attribute__((address_space(3)))
typedef unsigned short bf16_t;
typedef short bf16x8 __attribute__((ext_vector_type(8)));
typedef float f32x4 __attribute__((ext_vector_type(4)));
typedef unsigned u32x4 __attribute__((ext_vector_type(4)));
constexpr int BM = 256, BK = 64, HALF = 128, HTB = HALF * BK * 2  , STAGE_BYTES = 8 * HTB, NXCD = 8, WGM = 8;

__host__ __device__ __forceinline__ int lds_byte(int r, int c) { const int st = (r >> 4) * 2 + (c >> 5), rr = r & 15, cc = c & 31, ob = rr * 64 + cc * 2; return st * 1024 + (ob ^ (((ob >> 9) & 1) << 5)); }
__host__ __device__ __forceinline__ void stage_rc(int b, int& R, int& C) { const int st = b / 1024, sb = b % 1024, swz = sb ^ (((sb >> 9) & 1) << 5); R = (st >> 1) * 16 + swz / 64; C = (st & 1) * 32 + (swz % 64) / 2; }
__host__ __device__ __forceinline__ int perm32(int rho) { const int n = rho >> 4, i = rho & 15; return 8 * (i >> 2) + 4 * n + (i & 3); }

struct Unit { int pm, pn, k0, nt; };
struct Gemm { const bf16_t* A; const bf16_t* Bt; int M, N, K; };

__device__ __forceinline__ unsigned cvt_pk_bf16(float lo, float hi) { unsigned r; asm volatile("v_cvt_pk_bf16_f32 %0, %1, %2" : "=v"(r) : "v"(lo), "v"(hi)); return r; }
struct Order {
    int nM, nN, nwg, G, c, ntK, ex_n, ex_pm0, ex_pn0, ex_w, ex_split;
    __device__ __forceinline__ void init(int M, int N, int K, int G_, int c_) { nM = M / BM; nN = N / BM; nwg = nM * nN; G = G_; c = c_; ntK = K / BK; ex_n = 0; ex_pm0 = 0; ex_pn0 = 0; ex_w = 1; ex_split = 1; }
    __device__ __forceinline__ void extra(int n_units, int pm0, int pn0, int w, int split) { ex_n = n_units * split; ex_pm0 = pm0; ex_pn0 = pn0; ex_w = w; ex_split = split; }
    __device__ __forceinline__ bool next(int i, Unit& u) const {
        const long L = (long)i * G + c;
        const bool is_main = L < nwg;
        const int e = is_main ? 0 : (int)(L - nwg);
        const bool ok = is_main || e < ex_n;
        int wgid = is_main ? (int)L : 0; { const int q = nwg / NXCD, r = nwg % NXCD, xcd = wgid % NXCD, off = wgid / NXCD; wgid = (xcd < r ? xcd * (q + 1) : r * (q + 1) + (xcd - r) * q) + off; }
        const int nig = WGM * nN, gid = wgid / nig, fm = gid * WGM, gsz = (nM - fm) < WGM ? (nM - fm) : WGM;
        const int pm_m = fm + ((wgid % nig) % gsz), pn_m = (wgid % nig) / gsz;
        const int piece = e % ex_split, ue = e / ex_split, ntp = ntK / ex_split;
        const int pm_e = ex_pm0 + ue / ex_w, pn_e = ex_pn0 + ue % ex_w;
        Unit r; r.pm = is_main ? pm_m : pm_e; r.pn = is_main ? pn_m : pn_e; r.k0 = is_main ? 0 : piece * ntp; r.nt = is_main ? ntK : ntp;
        u = r; return ok;
    }
    __device__ __forceinline__ void a_ready(const Unit&) const {}
    __device__ __forceinline__ void done(const Unit&) const {}
};

__device__ __forceinline__ float fsigmoid(float x) { return __builtin_amdgcn_rcpf(1.0f + __expf(-x)); }
__device__ __forceinline__ float fsilu(float x) { return x * fsigmoid(x); }
__device__ __forceinline__ f32x4 bf4_lo(u32x4 w, int half) {
    const unsigned a = half ? w.z : w.x, b = half ? w.w : w.y;
    return (f32x4){__uint_as_float(a << 16), __uint_as_float(a & 0xffff0000u), __uint_as_float(b << 16), __uint_as_float(b & 0xffff0000u)};
}

struct EpiSwiGLU {
    static constexpr bool PERM = true, AFTER_DRAIN = false;
    bf16_t* O; int ldc;
    __device__ __forceinline__ void operator()(const f32x4 (&acc)[2][2][4][2], const Unit& u, int wr, int wc, int fr, int fq) const {
        const int row0 = u.pm * BM + wr * 64 + fr, col0 = u.pn * HALF + wc * 32 + 8 * fq;
#pragma unroll
        for (int ai = 0; ai < 2; ++ai)
#pragma unroll
            for (int m = 0; m < 4; ++m) {
                bf16_t* rowp = O + (size_t)(row0 + ai * HALF + m * 16) * ldc + col0;
                float r[8];
#pragma unroll
                for (int n = 0; n < 2; ++n)
#pragma unroll
                    for (int j = 0; j < 4; ++j) r[4 * n + j] = fsilu(acc[ai][1][m][n][j]) * acc[ai][0][m][n][j];
                u32x4 w; w.x = cvt_pk_bf16(r[0], r[1]); w.y = cvt_pk_bf16(r[2], r[3]); w.z = cvt_pk_bf16(r[4], r[5]); w.w = cvt_pk_bf16(r[6], r[7]);
                *(u32x4*)rowp = w;
            }
    }
};

struct EpiResid {
    static constexpr bool PERM = false, AFTER_DRAIN = false;
    const float* base_lat; const float* base_ctx; float* out; const float* gate; float scale;
    float* slab; int ntK;
    __device__ __forceinline__ void operator()(const f32x4 (&acc)[2][2][4][2], const Unit& u, int wr, int wc, int fr, int fq) const {
        const int row0 = u.pm * BM + wr * 64 + fr, col0 = u.pn * BM + wc * 32 + 4 * fq;
        if (u.nt != ntK) {
            float* sp = slab + ((size_t)(u.k0 / u.nt) * 1024 + (size_t)(row0 - 8192)) * 2048 + col0;
#pragma unroll
            for (int ai = 0; ai < 2; ++ai)
#pragma unroll
                for (int m = 0; m < 4; ++m)
#pragma unroll
                    for (int bj = 0; bj < 2; ++bj)
#pragma unroll
                        for (int n = 0; n < 2; ++n) *(f32x4*)(sp + (size_t)(ai * HALF + m * 16) * 2048 + bj * HALF + n * 16) = acc[ai][bj][m][n];
            return;
        }
        const int mrow = u.pm < 32 ? (u.pm >> 3) : 4;
        f32x4 gv[2][2];
#pragma unroll
        for (int bj = 0; bj < 2; ++bj)
#pragma unroll
            for (int n = 0; n < 2; ++n) gv[bj][n] = *(const f32x4*)(gate + (size_t)mrow * 18432 + col0 + bj * HALF + n * 16) * scale;
#pragma unroll
        for (int ai = 0; ai < 2; ++ai)
#pragma unroll
            for (int m = 0; m < 4; ++m) {
                const int r = row0 + ai * HALF + m * 16;
                const float* bp = (r < 8192 ? base_lat + (size_t)r * 2048 : base_ctx + (size_t)(r - 8192) * 2048) + col0;
                float* op = out + (size_t)r * 2048 + col0;
#pragma unroll
                for (int bj = 0; bj < 2; ++bj)
#pragma unroll
                    for (int n = 0; n < 2; ++n) *(f32x4*)(op + bj * HALF + n * 16) = *(const f32x4*)(bp + bj * HALF + n * 16) + gv[bj][n] * acc[ai][bj][m][n];
            }
    }
};

struct EpiProj {
    static constexpr bool PERM = true, AFTER_DRAIN = false;
    bf16_t* UCONV; bf16_t* SSMIN; bf16_t* GATES; const float* bias;
    __device__ __forceinline__ void operator()(const f32x4 (&acc)[2][2][4][2], const Unit& u, int wr, int wc, int fr, int fq) const {
        const int row0 = u.pm * BM + wr * 64 + fr, jj = wc * 32 + 8 * fq;
        if (u.pn < 8) {
            const int col0 = u.pn * HALF + jj;
            f32x4 ba[2], bg[2];
#pragma unroll
            for (int n = 0; n < 2; ++n) { ba[n] = *(const f32x4*)(bias + col0 + 4 * n); bg[n] = *(const f32x4*)(bias + 1024 + col0 + 4 * n); }
#pragma unroll
            for (int ai = 0; ai < 2; ++ai)
#pragma unroll
                for (int m = 0; m < 4; ++m) {
                    bf16_t* rowp = UCONV + (size_t)(row0 + ai * HALF + m * 16) * 1024 + col0;
                    float r[8];
#pragma unroll
                    for (int n = 0; n < 2; ++n)
#pragma unroll
                        for (int j = 0; j < 4; ++j) r[4 * n + j] = (acc[ai][0][m][n][j] + ba[n][j]) * fsigmoid(acc[ai][1][m][n][j] + bg[n][j]);
                    u32x4 w; w.x = cvt_pk_bf16(r[0], r[1]); w.y = cvt_pk_bf16(r[2], r[3]); w.z = cvt_pk_bf16(r[4], r[5]); w.w = cvt_pk_bf16(r[6], r[7]);
                    *(u32x4*)rowp = w;
                }
        } else {
            const bool is_gate = u.pn >= 12;
            bf16_t* O = is_gate ? GATES : SSMIN; const int ldc = is_gate ? 4096 : 1024;
            const int col0 = (is_gate ? (u.pn - 12) : (u.pn - 8)) * BM + jj, bcol0 = u.pn * BM + jj;
            f32x4 bv[2][2];
#pragma unroll
            for (int bj = 0; bj < 2; ++bj)
#pragma unroll
                for (int n = 0; n < 2; ++n) bv[bj][n] = *(const f32x4*)(bias + bcol0 + bj * HALF + 4 * n);
#pragma unroll
            for (int ai = 0; ai < 2; ++ai)
#pragma unroll
                for (int m = 0; m < 4; ++m) {
                    bf16_t* rowp = O + (size_t)(row0 + ai * HALF + m * 16) * ldc + col0;
#pragma unroll
                    for (int bj = 0; bj < 2; ++bj) {
                        f32x4 v0 = acc[ai][bj][m][0] + bv[bj][0], v1 = acc[ai][bj][m][1] + bv[bj][1];
                        if (is_gate) {
#pragma unroll
                            for (int j = 0; j < 4; ++j) { v0[j] = fsigmoid(v0[j]); v1[j] = fsigmoid(v1[j]); }
                        }
                        u32x4 w; w.x = cvt_pk_bf16(v0[0], v0[1]); w.y = cvt_pk_bf16(v0[2], v0[3]); w.z = cvt_pk_bf16(v1[0], v1[1]); w.w = cvt_pk_bf16(v1[2], v1[3]);
                        *(u32x4*)(rowp + bj * HALF) = w;
                    }
                }
        }
    }
};

struct EpiGluGate {
    static constexpr bool PERM = true, AFTER_DRAIN = false;
    bf16_t* T1; const bf16_t* GATES; const float* bias;
    __device__ __forceinline__ void operator()(const f32x4 (&acc)[2][2][4][2], const Unit& u, int wr, int wc, int fr, int fq) const {
        const int row0 = u.pm * BM + wr * 64 + fr, col0 = u.pn * HALF + wc * 32 + 8 * fq;
        f32x4 ba[2], bg[2];
#pragma unroll
        for (int n = 0; n < 2; ++n) { ba[n] = *(const f32x4*)(bias + col0 + 4 * n); bg[n] = *(const f32x4*)(bias + 2048 + col0 + 4 * n); }
#pragma unroll
        for (int ai = 0; ai < 2; ++ai)
#pragma unroll
            for (int m = 0; m < 4; ++m) {
                const size_t r = (size_t)(row0 + ai * HALF + m * 16);
                const u32x4 gw = *(const u32x4*)(GATES + r * 4096 + 2048 + col0);
                float rr[8];
#pragma unroll
                for (int n = 0; n < 2; ++n) { const f32x4 gs = bf4_lo(gw, n);
#pragma unroll
                    for (int j = 0; j < 4; ++j) rr[4 * n + j] = gs[j] * (acc[ai][0][m][n][j] + ba[n][j]) * fsigmoid(acc[ai][1][m][n][j] + bg[n][j]); }
                u32x4 w; w.x = cvt_pk_bf16(rr[0], rr[1]); w.y = cvt_pk_bf16(rr[2], rr[3]); w.z = cvt_pk_bf16(rr[4], rr[5]); w.w = cvt_pk_bf16(rr[6], rr[7]);
                *(u32x4*)(T1 + r * 2048 + col0) = w;
            }
    }
};

struct EpiConvMix {
    static constexpr bool PERM = true, AFTER_DRAIN = false;
    bf16_t* MIX; const bf16_t* GATES; const bf16_t* T1;
    __device__ __forceinline__ void operator()(const f32x4 (&acc)[2][2][4][2], const Unit& u, int wr, int wc, int fr, int fq) const {
        const int row0 = u.pm * BM + wr * 64 + fr, col0 = u.pn * BM + wc * 32 + 8 * fq;
#pragma unroll
        for (int ai = 0; ai < 2; ++ai)
#pragma unroll
            for (int m = 0; m < 4; ++m) {
                const size_t r = (size_t)(row0 + ai * HALF + m * 16);
#pragma unroll
                for (int bj = 0; bj < 2; ++bj) {
                    const u32x4 gw = *(const u32x4*)(GATES + r * 4096 + col0 + bj * HALF);
                    const u32x4 tw = *(const u32x4*)(T1 + r * 2048 + col0 + bj * HALF);
                    const f32x4 v0 = bf4_lo(gw, 0) * acc[ai][bj][m][0] + bf4_lo(tw, 0), v1 = bf4_lo(gw, 1) * acc[ai][bj][m][1] + bf4_lo(tw, 1);
                    u32x4 w; w.x = cvt_pk_bf16(v0[0], v0[1]); w.y = cvt_pk_bf16(v0[2], v0[3]); w.z = cvt_pk_bf16(v1[0], v1[1]); w.w = cvt_pk_bf16(v1[2], v1[3]);
                    *(u32x4*)(MIX + r * 2048 + col0 + bj * HALF) = w;
                }
            }
    }
};

template <class Epi, class Sched, bool ALIGN_EPI = false, bool SP2 = false>
__device__ __forceinline__ void gemm_phase(PG8_LAS unsigned char* lds, const Gemm g, const Sched& S, const Epi& E) {
    int tid_ = threadIdx.x; asm volatile("" : "+v"(tid_));
    const int tid = tid_, wid = __builtin_amdgcn_readfirstlane(tid >> 6), lane = tid & 63, wr = wid >> 2, wc = wid & 3, fr = lane & 15, fq = lane >> 4;
    const int K = g.K;
    unsigned voffA[2], voffB[2];
#pragma unroll
    for (int i = 0; i < 2; ++i) { int R, C; stage_rc(tid * 16 + i * 8192, R, C); const int Rb = Epi::PERM ? ((R & ~31) + perm32(R & 31)) : R;
        voffA[i] = (unsigned)(R * K + C) * 2u; voffB[i] = (unsigned)(Rb * BK + C) * 2u; }
    const size_t kstep = (size_t)(BK * 2);
    const size_t kstepB = (size_t)HTB;
    const size_t hstep = (size_t)HALF * K * 2;
    const size_t tstep = 2 * hstep;
    const unsigned ldsw = (unsigned)wid * 1024u;
    const int aoff = lds_byte(wr * 64 + fr, fq * 8), boff = lds_byte(wc * 32 + fr, fq * 8);
#define PG8_SA(b, h) (((b) * 2 + (h)) * HTB)
#define PG8_SB(b, h) ((4 + (b) * 2 + (h)) * HTB)
#define PG8_STAGE(bufoff, gbase, voff) do { _Pragma("unroll") for (int _i = 0; _i < 2; ++_i) \
        __builtin_amdgcn_global_load_lds((const unsigned*)((const char*)(gbase) + (voff)[_i]), (PG8_LAS unsigned*)(lds + (bufoff) + ldsw + _i * 8192), 16, 0, 0); } while (0)
#define PG8_LDA(dst, b, h) do { _Pragma("unroll") for (int m = 0; m < 4; ++m) _Pragma("unroll") for (int k = 0; k < 2; ++k) dst[m][k] = *(const PG8_LAS bf16x8*)(lds + PG8_SA(b, h) + aoff + m * 2048 + k * 1024); } while (0)
#define PG8_LDB(dst, b, h) do { _Pragma("unroll") for (int n = 0; n < 2; ++n) _Pragma("unroll") for (int k = 0; k < 2; ++k) dst[n][k] = *(const PG8_LAS bf16x8*)(lds + PG8_SB(b, h) + boff + n * 2048 + k * 1024); } while (0)
#define PG8_MMA(ai, bj, At, Bt) do { __builtin_amdgcn_s_setprio(1); _Pragma("unroll") for (int m = 0; m < 4; ++m) _Pragma("unroll") for (int n = 0; n < 2; ++n) _Pragma("unroll") for (int k = 0; k < 2; ++k) \
        acc[ai][bj][m][n] = __builtin_amdgcn_mfma_f32_16x16x32_bf16(Bt[n][k], At[m][k], acc[ai][bj][m][n], 0, 0, 0); __builtin_amdgcn_s_setprio(0); } while (0)
#define PG8_WAIT_V(n) asm volatile("s_waitcnt vmcnt(" #n ")" ::: "memory")
#define PG8_WAIT_L(n) asm volatile("s_waitcnt lgkmcnt(" #n ")" ::: "memory")
#define PG8_BAR __builtin_amdgcn_s_barrier()
#define PG8_SCHED __builtin_amdgcn_sched_barrier(0)
    Unit cur, nxt; int ui = 0;
    if (!S.next(0, cur)) return;
    f32x4 acc[2][2][4][2];
#pragma unroll
    for (int a = 0; a < 2; ++a)
#pragma unroll
        for (int b = 0; b < 2; ++b)
#pragma unroll
            for (int m = 0; m < 4; ++m)
#pragma unroll
                for (int n = 0; n < 2; ++n) acc[a][b][m][n] = (f32x4){0.f, 0.f, 0.f, 0.f};
    bf16x8 At[4][2], B0[2][2], B1[2][2];
    const char* cA = (const char*)g.A + (size_t)cur.pm * tstep + (size_t)cur.k0 * kstep; const char* cB = (const char*)g.Bt + (size_t)cur.pn * tstep + (size_t)cur.k0 * kstepB;
    S.a_ready(cur);
    if constexpr (SP2) {
        PG8_STAGE(PG8_SB(0, 0), cB, voffB); PG8_STAGE(PG8_SB(0, 1), cB + hstep, voffB); PG8_STAGE(PG8_SA(0, 0), cA, voffA); PG8_STAGE(PG8_SA(0, 1), cA + hstep, voffA);
        if (wr == 1) PG8_BAR;
        PG8_WAIT_V(2); PG8_BAR;
        PG8_STAGE(PG8_SB(1, 0), cB + kstepB, voffB); PG8_STAGE(PG8_SA(1, 0), cA + kstep, voffA); PG8_STAGE(PG8_SB(1, 1), cB + hstep + kstepB, voffB);
        PG8_WAIT_V(6); PG8_BAR;
    } else {
        PG8_STAGE(PG8_SB(0, 0), cB, voffB); PG8_STAGE(PG8_SA(0, 0), cA, voffA); PG8_STAGE(PG8_SB(0, 1), cB + hstep, voffB); PG8_STAGE(PG8_SA(0, 1), cA + hstep, voffA);
        if (wr == 1) PG8_BAR;
        PG8_WAIT_V(4); PG8_BAR;
        PG8_STAGE(PG8_SB(1, 0), cB + kstepB, voffB); PG8_STAGE(PG8_SA(1, 0), cA + kstep, voffA); PG8_STAGE(PG8_SB(1, 1), cB + hstep + kstepB, voffB);
        PG8_WAIT_V(6); PG8_BAR;
    }
    for (;;) {
        const bool has_next = S.next(ui + 1, nxt);
        const char* nA = has_next ? (const char*)g.A + (size_t)nxt.pm * tstep + (size_t)nxt.k0 * kstep : cA; const char* nB = has_next ? (const char*)g.Bt + (size_t)nxt.pn * tstep + (size_t)nxt.k0 * kstepB : cB;
        const int nt = cur.nt;
        for (int t = 0; t < nt; t += 2) {
            const bool last = (t == nt - 2);
            const char* a1 = cA + (size_t)(t + 1) * kstep;
            const char* a2 = last ? nA : cA + (size_t)(t + 2) * kstep; const char* b2 = last ? nB : cB + (size_t)(t + 2) * kstepB;
            const char* a3 = a2 + kstep; const char* b3 = b2 + kstepB;
            if (last && has_next) S.a_ready(nxt);
            if constexpr (SP2) {
            PG8_LDB(B0, 0, 0); PG8_LDB(B1, 0, 1); PG8_SCHED; PG8_LDA(At, 0, 0); PG8_STAGE(PG8_SA(1, 1), a1 + hstep, voffA);
            PG8_WAIT_V(8); PG8_WAIT_L(0); PG8_BAR; PG8_MMA(0, 0, At, B0); PG8_MMA(0, 1, At, B1); PG8_BAR; PG8_SCHED;
            PG8_LDA(At, 0, 1); PG8_STAGE(PG8_SB(0, 0), b2, voffB); PG8_STAGE(PG8_SB(0, 1), b2 + hstep, voffB); PG8_STAGE(PG8_SA(0, 0), a2, voffA);
            PG8_WAIT_V(8); PG8_WAIT_L(0); PG8_BAR; PG8_MMA(1, 0, At, B0); PG8_MMA(1, 1, At, B1); PG8_BAR; PG8_SCHED;
            PG8_LDB(B0, 1, 0); PG8_LDB(B1, 1, 1); PG8_SCHED; PG8_LDA(At, 1, 0); PG8_STAGE(PG8_SA(0, 1), a2 + hstep, voffA);
            PG8_WAIT_V(8); PG8_WAIT_L(0); PG8_BAR; PG8_MMA(0, 0, At, B0); PG8_MMA(0, 1, At, B1); PG8_BAR; PG8_SCHED;
            PG8_LDA(At, 1, 1); PG8_STAGE(PG8_SB(1, 0), b3, voffB); PG8_STAGE(PG8_SB(1, 1), b3 + hstep, voffB); PG8_STAGE(PG8_SA(1, 0), a3, voffA);
            PG8_WAIT_V(8); PG8_WAIT_L(0); PG8_BAR; PG8_MMA(1, 0, At, B0); PG8_MMA(1, 1, At, B1); PG8_BAR; PG8_SCHED;
            } else {
            PG8_LDB(B0, 0, 0); PG8_SCHED; PG8_LDA(At, 0, 0); PG8_STAGE(PG8_SA(1, 1), a1 + hstep, voffA);
            PG8_WAIT_L(8); PG8_BAR; PG8_WAIT_L(0); PG8_MMA(0, 0, At, B0); PG8_BAR; PG8_SCHED;
            PG8_LDB(B1, 0, 1); PG8_STAGE(PG8_SB(0, 0), b2, voffB);
            PG8_BAR; PG8_WAIT_L(0); PG8_MMA(0, 1, At, B1); PG8_BAR;
            PG8_LDA(At, 0, 1); PG8_STAGE(PG8_SA(0, 0), a2, voffA);
            PG8_BAR; PG8_WAIT_L(0); PG8_MMA(1, 0, At, B0); PG8_BAR; PG8_SCHED;
            PG8_STAGE(PG8_SB(0, 1), b2 + hstep, voffB);
            PG8_WAIT_V(6); PG8_BAR; PG8_MMA(1, 1, At, B1); PG8_BAR;
            PG8_LDB(B0, 1, 0); PG8_SCHED; PG8_LDA(At, 1, 0); PG8_STAGE(PG8_SA(0, 1), a2 + hstep, voffA);
            PG8_WAIT_L(8); PG8_BAR; PG8_WAIT_L(0); PG8_MMA(0, 0, At, B0); PG8_BAR; PG8_SCHED;
            PG8_LDB(B1, 1, 1); PG8_STAGE(PG8_SB(1, 0), b3, voffB);
            PG8_BAR; PG8_WAIT_L(0); PG8_MMA(0, 1, At, B1); PG8_BAR;
            PG8_LDA(At, 1, 1); PG8_STAGE(PG8_SA(1, 0), a3, voffA);
            PG8_BAR; PG8_WAIT_L(0); PG8_MMA(1, 0, At, B0); PG8_BAR; PG8_SCHED;
            PG8_STAGE(PG8_SB(1, 1), b3 + hstep, voffB);
            PG8_WAIT_V(6); PG8_BAR; PG8_MMA(1, 1, At, B1); PG8_BAR;
            }
        }
        if constexpr (ALIGN_EPI) { if (wr == 0) PG8_BAR; }
        if constexpr (!Epi::AFTER_DRAIN) { E(acc, cur, wr, wc, fr, fq); S.done(cur); }
        if (!has_next) break;
#pragma unroll
        for (int a = 0; a < 2; ++a)
#pragma unroll
            for (int b = 0; b < 2; ++b)
#pragma unroll
                for (int m = 0; m < 4; ++m)
#pragma unroll
                    for (int n = 0; n < 2; ++n) acc[a][b][m][n] = (f32x4){0.f, 0.f, 0.f, 0.f};
        cur = nxt; cA = nA; cB = nB; ++ui;
        if constexpr (ALIGN_EPI) { if (wr == 1) PG8_BAR; }
    }
    PG8_WAIT_V(0);
    if constexpr (!ALIGN_EPI) { if (wr == 0) PG8_BAR; }
    PG8_BAR;
    if constexpr (Epi::AFTER_DRAIN) { E.fused(acc, cur, wr, wc, fr, fq, lds, wid, lane); S.done(cur); }
#undef PG8_SA
#undef PG8_SB
#undef PG8_STAGE
#undef PG8_LDA
#undef PG8_LDB
#undef PG8_MMA
#undef PG8_WAIT_V
#undef PG8_WAIT_L
#undef PG8_BAR
#undef PG8_SCHED
}
}
#define GAS __attribute__((address_space(1)))
#define LAS __attribute__((address_space(3)))
typedef unsigned short bf16;
typedef unsigned v4u __attribute__((ext_vector_type(4)));
typedef float f32x4 __attribute__((ext_vector_type(4)));
typedef short bf16x8 __attribute__((ext_vector_type(8)));
typedef GAS unsigned gu32;
typedef GAS unsigned long long gu64;
#define RLX_AGENT __ATOMIC_RELAXED, __HIP_MEMORY_SCOPE_AGENT
#define LDS_WAIT() asm volatile("s_waitcnt lgkmcnt(0)" ::: "memory")
#define VM_WAIT() asm volatile("s_waitcnt vmcnt(0)" ::: "memory")
__device__ __forceinline__ unsigned long long rt() { return __builtin_amdgcn_s_memrealtime(); }
__device__ __forceinline__ unsigned f2bf(float f) { unsigned u = __builtin_bit_cast(unsigned, f); return (u + 0x7fffu + ((u >> 16) & 1u)) >> 16; }
__device__ __forceinline__ unsigned pk2(float lo, float hi) { return f2bf(lo) | (f2bf(hi) << 16); }
#define XB_TMO      128
#define XB_XCNT(j)  (256  + 64 * (j))
#define XB_XSUB(j)  (1280 + 64 * (j))
#define XB_XGEN(j)  (2304 + 64 * (j))
#define XB_TOP      3328
#define XB_TOPGEN   3392
#define XCD_BAR_WORDS 3456
#define XB_SPIN_CAP (1u << 18)

__device__ __forceinline__ unsigned xb_ld(unsigned* p)              { return __hip_atomic_load(p, __ATOMIC_RELAXED, __HIP_MEMORY_SCOPE_AGENT); }
__device__ __forceinline__ unsigned xb_add(unsigned* p, unsigned v) { return __hip_atomic_fetch_add(p, v, __ATOMIC_RELAXED, __HIP_MEMORY_SCOPE_AGENT); }
__device__ __forceinline__ unsigned xb_xcc_id() { return (unsigned)__builtin_amdgcn_s_getreg((3 << 11) | 20) & 0xFu; }
#define XB_SPIN(cond, bar) do { unsigned _sp = 0; while (cond) { __builtin_amdgcn_s_sleep(1); \
    if ((++_sp & 255u) == 0u) { if (xb_ld(&(bar)[XB_TMO])) break; if (_sp > XB_SPIN_CAP) { atomicAdd(&(bar)[XB_TMO], 1u); break; } } } } while (0)

struct XcdBarrier {
    unsigned* bar; unsigned x;
    volatile LAS unsigned* st;
};

__device__ __forceinline__ XcdBarrier xcd_barrier_post(unsigned* bar, volatile LAS unsigned* st) {
    XcdBarrier b; b.bar = bar; b.x = xb_xcc_id(); b.st = st;
    if (threadIdx.x == 0) (void)xb_add(&bar[XB_XCNT(b.x)], 1u);
    return b;
}
__device__ __forceinline__ void xcd_barrier_complete(unsigned* bar, unsigned x, unsigned& nloc, unsigned& nx) {
    const unsigned G = gridDim.x * gridDim.y * gridDim.z;
    unsigned sum, cnt, mine, sp = 0u;
    for (;;) {
        sum = 0u; cnt = 0u; mine = 0u;
#pragma unroll
        for (unsigned j = 0; j < 16; ++j) { const unsigned c = xb_ld(&bar[XB_XCNT(j)]); sum += c; cnt += (c > 0u) ? 1u : 0u; mine = (j == x) ? c : mine; }
        if (sum == G) break;
        __builtin_amdgcn_s_sleep(1);
        if ((++sp & 255u) == 0u) { if (xb_ld(&bar[XB_TMO])) break; if (sp > XB_SPIN_CAP) { atomicAdd(&bar[XB_TMO], 1u); break; } }
    }
    nloc = mine > 0u ? mine : 1u; nx = cnt > 0u ? cnt : 1u;
}

__device__ __forceinline__ void xcd_barrier(const XcdBarrier& b) {
    asm volatile("s_waitcnt vmcnt(0)" ::: "memory");
    __syncthreads();
    if (threadIdx.x == 0) {
        unsigned* bar = b.bar;
        __builtin_amdgcn_s_waitcnt(0);
        unsigned nloc = b.st[0], nx = b.st[1];
        if (nloc == 0u) { xcd_barrier_complete(bar, b.x, nloc, nx); b.st[0] = nloc; b.st[1] = nx; }
        const unsigned old = xb_add(&bar[XB_XSUB(b.x)], 1u);
        const unsigned gen = old / nloc;
        if (old + 1u == (gen + 1u) * nloc) {
            __builtin_amdgcn_fence(__ATOMIC_RELEASE, "agent");
            asm volatile("s_waitcnt vmcnt(0)" ::: "memory");
            const unsigned og = xb_add(&bar[XB_TOP], 1u);
            const unsigned tg = og / nx;
            if (og + 1u == (tg + 1u) * nx) xb_add(&bar[XB_TOPGEN], 1u);
            else XB_SPIN(xb_ld(&bar[XB_TOPGEN]) == tg, bar);
            __builtin_amdgcn_fence(__ATOMIC_ACQUIRE, "agent");
            xb_add(&bar[XB_XGEN(b.x)], 1u);
            asm volatile("s_waitcnt vmcnt(0)" ::: "memory");
        } else {
            XB_SPIN(xb_ld(&bar[XB_XGEN(b.x)]) == gen, bar);
            __builtin_amdgcn_fence(__ATOMIC_ACQUIRE, "agent");
            asm volatile("s_waitcnt vmcnt(0)" ::: "memory");
        }
    }
    __syncthreads();
}
constexpr int NWAVES = 8;
constexpr int DM = 2048, NBATCH = 4, SEQ = 2048, CTXL = 256, DFF = 5632, CDIM = 1024, CONVK = 31, SDIM = 1024, NGRP = 64, NST = 64, NIN = 7168, MODW = 9 * DM;
constexpr int ML = NBATCH * SEQ, MC = NBATCH * CTXL, MT = ML + MC;
constexpr float EPS = 1e-6f;
#ifndef MK_PER_PHASE
#define MK_PER_PHASE 0
#endif

constexpr size_t MiB = 1u << 20;
constexpr size_t WS_CTL = 0, WS_MOD = 1 * MiB, ZERO_BYTES = 2 * MiB;
constexpr size_t WS_LAM = 2 * MiB, WS_LAMT = WS_LAM + 128 * 1024, WS_BOP = 3 * MiB, WS_COP = 4 * MiB;
constexpr size_t WS_W = 6 * MiB, W_LAYER = 180 * MiB;
constexpr size_t WO_UP1 = 0, WO_DN1 = 44 * MiB, WO_IN = 66 * MiB, WO_CO = 94 * MiB, WO_GLU = 98 * MiB, WO_OUT = 106 * MiB, WO_UP2 = 114 * MiB, WO_DN2 = 158 * MiB;
constexpr size_t WS_X = 366 * MiB, WS_H = 438 * MiB, WS_ACT = 474 * MiB, WS_UCONV = 573 * MiB, WS_SSMIN = 591 * MiB, WS_GATES = 609 * MiB, WS_CONVACT = 681 * MiB, WS_SSMACT = 699 * MiB;
constexpr size_t WS_YF = 717 * MiB, WS_YB = 753 * MiB, WS_T1 = 789 * MiB, WS_MIX = 825 * MiB, WS_E = 861 * MiB, WS_SLAB = 864 * MiB, WS_END = 928 * MiB;
constexpr int CW_TMO = 0, CW_BAR = 4096;
constexpr int RING_OFF = 0, RING_BYTES = 131072, LDSCTL_OFF = RING_BYTES, MISC_OFF = LDSCTL_OFF + 320, LDS_BYTES = 147456;

#ifndef REPMASK
#define REPMASK 0u
#endif
#ifndef REPN
#define REPN 2
#endif
#define REP(s) for (int rep_ = 0; rep_ < ((((REPMASK) >> (s)) & 1u) ? REPN : 1); ++rep_)
typedef float f32x2 __attribute__((ext_vector_type(2)));
typedef float f32x16 __attribute__((ext_vector_type(16)));
typedef unsigned u32x2 __attribute__((ext_vector_type(2)));
__device__ __forceinline__ float wave_sum(float v) {
#pragma unroll
    for (int o = 1; o < 64; o <<= 1) v += __shfl_xor(v, o);
    return v;
}
__device__ __forceinline__ unsigned pkbf(float lo, float hi) { return pg8::cvt_pk_bf16(lo, hi); }
__device__ __forceinline__ float bf_lo(unsigned w) { return __uint_as_float(w << 16); }
__device__ __forceinline__ float bf_hi(unsigned w) { return __uint_as_float(w & 0xffff0000u); }
__device__ __forceinline__ float gelu_tanh(float x) {
    const float z = 0.7978845608028654f * (x + 0.044715f * x * x * x);
    const float e = __expf(2.0f * z);
    const float t = 1.0f - 2.0f * __builtin_amdgcn_rcpf(e + 1.0f);
    return 0.5f * x * (1.0f + t);
}
__device__ __forceinline__ float sigm(float x) { return __builtin_amdgcn_rcpf(1.0f + __expf(-x)); }

struct Args { const float* in[32]; float* out; unsigned char* ws; int ph_lo, ph_hi; };

struct Frame {
    LAS unsigned char* lds;
    int tid, lane, wave, vcu, G;
    unsigned char* ws;
};

__device__ __forceinline__ Frame refresh(const Frame& F0) { Frame F = F0; int t = threadIdx.x; asm volatile("" : "+v"(t)); F.tid = t; F.lane = t & 63; F.wave = __builtin_amdgcn_readfirstlane(t >> 6); return F; }
__device__ __forceinline__ void transpose_item(const float* W, int K, int N, bf16* WT, int k0, int n0, int drow0, LAS float* scr, int lane) {
#pragma unroll 8
    for (int i = 0; i < 32; ++i) { const int kk = 2 * i + (lane >> 5); scr[kk * 33 + (lane & 31)] = W[(size_t)(k0 + kk) * N + n0 + (lane & 31)]; }
    LDS_WAIT(); asm volatile("" ::: "memory");
    const int c = lane & 7;
#pragma unroll
    for (int j = 0; j < 4; ++j) { const int n = (lane >> 3) + 8 * j; const LAS float* s = scr + (8 * c) * 33 + n;
        v4u o; o.x = pkbf(s[0 * 33], s[1 * 33]); o.y = pkbf(s[2 * 33], s[3 * 33]); o.z = pkbf(s[4 * 33], s[5 * 33]); o.w = pkbf(s[6 * 33], s[7 * 33]);
        const int dr = drow0 + n;
        *(GAS v4u*)(WT + ((size_t)(dr >> 7) * (K >> 6) + (k0 >> 6)) * 8192 + (size_t)(dr & 127) * 64 + 8 * c) = o; }
    LDS_WAIT(); asm volatile("" ::: "memory");
}
__device__ __forceinline__ int glu_row(int n, int HC) { const int half = n >= HC ? 1 : 0, j = n - half * HC; return (j >> 7) * 256 + half * 128 + (j & 127); }

__device__ __forceinline__ void phase_prologue(const Frame& F0, const Args& args) {
    const Frame F = refresh(F0);
    const int gw = F.vcu * NWAVES + F.wave, NGW = F.G * NWAVES;
    unsigned char* ws = F.ws;
    {
        LAS float* sc = (LAS float*)(F.lds + RING_OFF);
        const float* c = args.in[1]; const float* cc = args.in[3];
        for (int i = F.tid; i < 5 * DM; i += NWAVES * 64) { const float v = i < 4 * DM ? c[i] : cc[i - 4 * DM]; sc[i] = v * sigm(v); }
        __syncthreads();
        const float* ada_w = args.in[4]; const float* ada_b = args.in[5];
        float* MOD = (float*)(ws + WS_MOD);
        REP(15) for (int it = gw; it < 288 * 8; it += NGW) {
            const float repz = rep_ ? 0.f : 1.f;
            const int cb = it >> 3, kc = it & 7, l = cb / 144, n0 = (cb % 144) * 128 + 2 * F.lane;
            const float* wp = ada_w + ((size_t)l * DM + (size_t)kc * 256) * MODW + n0;
            f32x2 a0 = {0.f, 0.f}, a1 = a0, a2 = a0, a3 = a0, a4 = a0;
            const LAS float* s = sc + kc * 256;
#pragma unroll 8
            for (int k = 0; k < 256; ++k) { const f32x2 w = *(const f32x2*)(wp + (size_t)k * MODW);
                a0 += w * s[k]; a1 += w * s[DM + k]; a2 += w * s[2 * DM + k]; a3 += w * s[3 * DM + k]; a4 += w * s[4 * DM + k]; }
            if (kc == 0) { const f32x2 b = *(const f32x2*)(ada_b + (size_t)l * MODW + n0); a0 += b; a1 += b; a2 += b; a3 += b; a4 += b; }
            float* mp = MOD + (size_t)l * 5 * MODW + n0;
            atomicAdd(mp + 0 * MODW, a0.x * repz); atomicAdd(mp + 0 * MODW + 1, a0.y * repz);
            atomicAdd(mp + 1 * MODW, a1.x * repz); atomicAdd(mp + 1 * MODW + 1, a1.y * repz);
            atomicAdd(mp + 2 * MODW, a2.x * repz); atomicAdd(mp + 2 * MODW + 1, a2.y * repz);
            atomicAdd(mp + 3 * MODW, a3.x * repz); atomicAdd(mp + 3 * MODW + 1, a3.y * repz);
            atomicAdd(mp + 4 * MODW, a4.x * repz); atomicAdd(mp + 4 * MODW + 1, a4.y * repz);
        }
        __syncthreads();
    }
    {
        f32x2* LAM = (f32x2*)(ws + WS_LAM); f32x2* LAMT = (f32x2*)(ws + WS_LAMT); bf16* BOP = (bf16*)(ws + WS_BOP); bf16* COP = (bf16*)(ws + WS_COP);
        const float *a_re = args.in[17], *a_im = args.in[18], *log_dt = args.in[19], *b_re = args.in[20], *b_im = args.in[21], *c_re = args.in[22], *c_im = args.in[23];
        for (int it = F.vcu * (NWAVES * 64) + F.tid; it < 2 * 2 * NGRP * NST; it += F.G * NWAVES * 64) {
            const int p = it & 63, ldg = it >> 6;
            const float ar = a_re[it], ai = a_im[it], dt = expf(log_dt[ldg]);
            const float er = expf(ar * dt), lr = er * cosf(ai * dt), li = er * sinf(ai * dt);
            LAM[it] = (f32x2){lr, li};
            float tr = lr, ti = li;
#pragma unroll
            for (int s = 0; s < 5; ++s) { const float nr = tr * tr - ti * ti, ni = 2.f * tr * ti; tr = nr; ti = ni; }
            const float t32r = tr, t32i = ti;
#pragma unroll
            for (int s = 0; s < 3; ++s) { const float nr = tr * tr - ti * ti, ni = 2.f * tr * ti; tr = nr; ti = ni; }
            LAMT[it] = (f32x2){tr * t32r - ti * t32i, tr * t32i + ti * t32r};
            const float nr = lr - 1.f, ni = li, den = 1.f / (ar * ar + ai * ai);
            const float cr = (nr * ar + ni * ai) * den, ci = (ni * ar - nr * ai) * den;
            const int jj = p & 31, hi = p >> 5;
            for (int c = 0; c < 16; ++c) {
                const float br = b_re[(size_t)it * 16 + c], bi = b_im[(size_t)it * 16 + c];
                const float vr = cr * br - ci * bi, vi = cr * bi + ci * br;
                const int lane = jj + 32 * (c >> 3), j = c & 7;
                BOP[(((size_t)ldg * 4 + (hi ? 1 : 0)) * 64 + lane) * 8 + j] = (bf16)(pkbf(vr, 0.f) & 0xffffu);
                BOP[(((size_t)ldg * 4 + (hi ? 3 : 2)) * 64 + lane) * 8 + j] = (bf16)(pkbf(vi, 0.f) & 0xffffu);
                const float cre = c_re[((size_t)ldg * 16 + c) * 64 + p], cim = c_im[((size_t)ldg * 16 + c) * 64 + p];
                const int kk = 4 * jj + (hi ? 2 : 0);
                const int ks = kk >> 5, q = (kk & 31) >> 3, j2 = kk & 7, lane2 = c + 16 * q;
                COP[(((size_t)ldg * 4 + ks) * 64 + lane2) * 8 + j2] = (bf16)(pkbf(cre, 0.f) & 0xffffu);
                COP[(((size_t)ldg * 4 + ks) * 64 + lane2) * 8 + j2 + 1] = (bf16)(pkbf(-cim, 0.f) & 0xffffu);
            }
        }
    }
    {
        LAS float* scr = (LAS float*)(F.lds + RING_OFF + F.wave * 16384);
        constexpr int I_UP = (DM / 64) * (2 * DFF / 32), I_DN = (DFF / 64) * (DM / 32), I_IN = (DM / 64) * (NIN / 32), I_CO = (CDIM / 64) * (DM / 32), I_GLU = (SDIM / 64) * (2 * DM / 32), I_OUT = (DM / 64) * (DM / 32);
        constexpr int I_LAYER = 2 * I_UP + 2 * I_DN + I_IN + I_CO + I_GLU + I_OUT;
        REP(14) for (int it = gw; it < 2 * I_LAYER; it += NGW) {
            const int l = it / I_LAYER; int r = it % I_LAYER;
            unsigned char* wl = ws + WS_W + (size_t)l * W_LAYER;
            const float* W; int K, N, kind; bf16* WT;
            if (r < I_UP) { W = args.in[7] + (size_t)l * DM * 2 * DFF; K = DM; N = 2 * DFF; kind = 1; WT = (bf16*)(wl + WO_UP1); }
            else if ((r -= I_UP) < I_DN) { W = args.in[8] + (size_t)l * DFF * DM; K = DFF; N = DM; kind = 0; WT = (bf16*)(wl + WO_DN1); }
            else if ((r -= I_DN) < I_IN) { W = args.in[10] + (size_t)l * DM * NIN; K = DM; N = NIN; kind = 2; WT = (bf16*)(wl + WO_IN); }
            else if ((r -= I_IN) < I_CO) { W = args.in[16] + (size_t)l * CDIM * DM; K = CDIM; N = DM; kind = 0; WT = (bf16*)(wl + WO_CO); }
            else if ((r -= I_CO) < I_GLU) { W = args.in[25] + (size_t)l * SDIM * 2 * DM; K = SDIM; N = 2 * DM; kind = 1; WT = (bf16*)(wl + WO_GLU); }
            else if ((r -= I_GLU) < I_OUT) { W = args.in[27] + (size_t)l * DM * DM; K = DM; N = DM; kind = 0; WT = (bf16*)(wl + WO_OUT); }
            else if ((r -= I_OUT) < I_UP) { W = args.in[29] + (size_t)l * DM * 2 * DFF; K = DM; N = 2 * DFF; kind = 1; WT = (bf16*)(wl + WO_UP2); }
            else { r -= I_UP; W = args.in[30] + (size_t)l * DFF * DM; K = DFF; N = DM; kind = 0; WT = (bf16*)(wl + WO_DN2); }
            const int nblk = N / 32, kb = r / nblk, nb = r % nblk, n0 = 32 * nb;
            int drow0 = n0;
            if (kind == 1) drow0 = glu_row(n0, N / 2);
            else if (kind == 2 && n0 < 2048) drow0 = glu_row(n0, 1024);
            transpose_item(W, K, N, WT, 64 * kb, n0, drow0, scr, F.lane);
        }
    }
}

template <int NSLAB>
__device__ __forceinline__ void phase_norm_t(const Frame& F0, const float* src_lat, const float* src_ctx, const float* gain, const float* mod, bf16* H, int nrows,
                                             const float* slab, const float* gate, float gscale, float* Xc_out) {
    const Frame F = refresh(F0);
    const int gw = F.vcu * NWAVES + F.wave, NGW = F.G * NWAVES;
    const int nctx = nrows > ML ? nrows - ML : 0;
    const float* gp = gain + 4 * F.lane;
    for (int w = gw; w < ML / 4; w += NGW) {
        const int r0 = 4 * w, mrow = r0 >> 11;
        const float* sh = mod + (size_t)mrow * MODW + 4 * F.lane;
        f32x4 A[8], S[8], vn[8];
        const float* xr = src_lat + (size_t)r0 * DM + 4 * F.lane;
#pragma unroll
        for (int j = 0; j < 8; ++j) vn[j] = *(const f32x4*)(xr + 256 * j);
#pragma unroll
        for (int j = 0; j < 8; ++j) { A[j] = *(const f32x4*)(gp + 256 * j) * (*(const f32x4*)(sh + DM + 256 * j) + 1.0f); S[j] = *(const f32x4*)(sh + 256 * j); }
#pragma unroll
        for (int i = 0; i < 4; ++i) {
            f32x4 v[8];
#pragma unroll
            for (int j = 0; j < 8; ++j) v[j] = vn[j];
            if (i < 3) {
#pragma unroll
                for (int j = 0; j < 8; ++j) vn[j] = *(const f32x4*)(xr + (size_t)(i + 1) * DM + 256 * j); }
            float ss = 0.f;
#pragma unroll
            for (int j = 0; j < 8; ++j) ss += (v[j].x * v[j].x + v[j].y * v[j].y) + (v[j].z * v[j].z + v[j].w * v[j].w);
            const float rstd = 1.0f / sqrtf(wave_sum(ss) * (1.0f / DM) + EPS);
            bf16* orow = H + (size_t)(r0 + i) * DM + 4 * F.lane;
#pragma unroll
            for (int j = 0; j < 8; ++j) { const f32x4 o = (v[j] * rstd) * A[j] + S[j]; u32x2 wv; wv.x = pkbf(o.x, o.y); wv.y = pkbf(o.z, o.w); *(u32x2*)(orow + 256 * j) = wv; }
        }
    }
    for (int w = gw; w < nctx; w += NGW) {
        const float* xr = src_ctx + (size_t)w * DM + 4 * F.lane;
        const float* sh = mod + (size_t)4 * MODW + 4 * F.lane;
        f32x4 v[8];
#pragma unroll
        for (int j = 0; j < 8; ++j) v[j] = *(const f32x4*)(xr + 256 * j);
        if (NSLAB > 0) {
            const float* sp = slab + (size_t)w * DM + 4 * F.lane; const float* gtp = gate + (size_t)4 * MODW + 4 * F.lane; float* xo = Xc_out + (size_t)w * DM + 4 * F.lane;
#pragma unroll
            for (int j = 0; j < 8; ++j) { f32x4 a = *(const f32x4*)(sp + 256 * j);
#pragma unroll
                for (int sidx = 1; sidx < NSLAB; ++sidx) a += *(const f32x4*)(sp + (size_t)sidx * MC * DM + 256 * j);
                v[j] += *(const f32x4*)(gtp + 256 * j) * gscale * a; *(f32x4*)(xo + 256 * j) = v[j]; }
        }
        float ss = 0.f;
#pragma unroll
        for (int j = 0; j < 8; ++j) ss += (v[j].x * v[j].x + v[j].y * v[j].y) + (v[j].z * v[j].z + v[j].w * v[j].w);
        const float rstd = 1.0f / sqrtf(wave_sum(ss) * (1.0f / DM) + EPS);
        bf16* orow = H + (size_t)(ML + w) * DM + 4 * F.lane;
#pragma unroll
        for (int j = 0; j < 8; ++j) {
            const f32x4 g4 = *(const f32x4*)(gp + 256 * j), s4 = *(const f32x4*)(sh + 256 * j), c4 = *(const f32x4*)(sh + DM + 256 * j);
            const f32x4 o = (v[j] * rstd * g4) * (c4 + 1.0f) + s4;
            u32x2 wv; wv.x = pkbf(o.x, o.y); wv.y = pkbf(o.z, o.w);
            *(u32x2*)(orow + 256 * j) = wv;
        }
    }
}
__device__ __forceinline__ void phase_norm(const Frame& F, const float* src_lat, const float* src_ctx, const float* gain, const float* mod, bf16* H, int nrows,
                                           const float* slab, int nslab, const float* gate, float gscale, float* Xc_out) {
    if (nslab == 8) phase_norm_t<8>(F, src_lat, src_ctx, gain, mod, H, nrows, slab, gate, gscale, Xc_out);
    else if (nslab == 4) phase_norm_t<4>(F, src_lat, src_ctx, gain, mod, H, nrows, slab, gate, gscale, Xc_out);
    else phase_norm_t<0>(F, src_lat, src_ctx, gain, mod, H, nrows, slab, gate, gscale, Xc_out);
}
__device__ __forceinline__ void phase_final(const Frame& F0, const float* X, const float* gain, float* out) {
    const Frame F = refresh(F0);
    const int gw = F.vcu * NWAVES + F.wave, NGW = F.G * NWAVES;
    for (int row = gw; row < ML; row += NGW) {
        const float* xr = X + (size_t)row * DM + 4 * F.lane;
        f32x4 v[8]; float ss = 0.f;
#pragma unroll
        for (int j = 0; j < 8; ++j) { v[j] = *(const f32x4*)(xr + 256 * j); ss += (v[j].x * v[j].x + v[j].y * v[j].y) + (v[j].z * v[j].z + v[j].w * v[j].w); }
        const float rstd = 1.0f / sqrtf(wave_sum(ss) * (1.0f / DM) + EPS);
        float* orow = out + (size_t)row * DM + 4 * F.lane; const float* gp = gain + 4 * F.lane;
#pragma unroll
        for (int j = 0; j < 8; ++j) *(f32x4*)(orow + 256 * j) = v[j] * rstd * *(const f32x4*)(gp + 256 * j);
    }
}

__device__ __forceinline__ void phase_conv(const Frame& F0, const bf16* UCONV, const float* dw, const float* db, const float* lng, const float* lnb, bf16* CONVACT, int nunits) {
    const Frame F = refresh(F0);
    LAS float* WL = (LAS float*)(F.lds + RING_OFF);
    LAS float* red = (LAS float*)(F.lds + RING_OFF + CONVK * CDIM * 4);
    __syncthreads();
    for (int i = F.tid; i < CONVK * CDIM / 4; i += NWAVES * 64) *(LAS f32x4*)(WL + 4 * i) = *(const f32x4*)(dw + 4 * i);
    __syncthreads();
    const int cg = F.tid & 127, q = F.tid >> 7, ch = 8 * cg;
    const bool vert_wave = (F.wave & 1) != 0;
    f32x4 bias[2], g2[2], b2[2];
#pragma unroll
    for (int h = 0; h < 2; ++h) { bias[h] = *(const f32x4*)(db + ch + 4 * h); g2[h] = *(const f32x4*)(lng + ch + 4 * h); b2[h] = *(const f32x4*)(lnb + ch + 4 * h); }
    const LAS float* wl = WL + ch;
    for (int unit = F.vcu; unit < nunits; unit += F.G) {
        const bool is_ctx = unit >= 512;
        const int bb = unit >> 7, r0 = ((unit >> 4) & 7) * 4, w0 = (unit & 15) * 4;
        const int tokc = ML + (unit - 512) * 16;
        int lbase, lstride, lo, len;
        if (is_ctx) { const int base = ML + ((tokc - ML) & ~255); lbase = base; lstride = 1; lo = (tokc - base) + 4 * q - 15; len = 256; }
        else if (!vert_wave) { lbase = bb * SEQ + (r0 + q) * 64; lstride = 1; lo = w0 - 15; len = 64; }
        else { lbase = bb * SEQ + w0 + q; lstride = 64; lo = r0 - 15; len = 32; }
        const bf16* up = UCONV + ch;
        f32x4 o[4][2];
#pragma unroll
        for (int i = 0; i < 4; ++i) { o[i][0] = bias[0]; o[i][1] = bias[1]; }
        f32x4 wr[4][2];
#pragma unroll
        for (int j = 0; j < 34; ++j) {
            const int pos = lo + j; const bool ok = pos >= 0 && pos < len; const int pc = pos < 0 ? 0 : (pos >= len ? len - 1 : pos);
            const pg8::u32x4 xw = *(const pg8::u32x4*)(up + (size_t)(lbase + pc * lstride) * CDIM);
            const float m = ok ? 1.f : 0.f;
            const f32x4 x0 = pg8::bf4_lo(xw, 0) * m, x1 = pg8::bf4_lo(xw, 1) * m;
            if (j < CONVK) { wr[j & 3][0] = *(const LAS f32x4*)(wl + j * CDIM); wr[j & 3][1] = *(const LAS f32x4*)(wl + j * CDIM + 4); }
#pragma unroll
            for (int i = 0; i < 4; ++i) { const int k = j - i; if (k >= 0 && k < CONVK) { o[i][0] += wr[k & 3][0] * x0; o[i][1] += wr[k & 3][1] * x1; } }
        }
        float v[8];
#pragma unroll
        for (int i = 0; i < 4; ++i) {
            v[i] = (o[i][0][0] + o[i][0][1]) + (o[i][0][2] + o[i][0][3]) + (o[i][1][0] + o[i][1][1]) + (o[i][1][2] + o[i][1][3]);
            const f32x4 s0 = o[i][0] * o[i][0], s1 = o[i][1] * o[i][1];
            v[4 + i] = (s0[0] + s0[1]) + (s0[2] + s0[3]) + (s1[0] + s1[1]) + (s1[2] + s1[3]);
        }
#define BFLY(HALF, BIT) { const bool hi = (F.lane & BIT) != 0; _Pragma("unroll") for (int i = 0; i < HALF; ++i) { const float send = hi ? v[i] : v[HALF + i], keep = hi ? v[HALF + i] : v[i]; v[i] = keep + __shfl_xor(send, BIT); } }
        BFLY(4, 32) BFLY(2, 16) BFLY(1, 8)
#undef BFLY
        v[0] += __shfl_xor(v[0], 4); v[0] += __shfl_xor(v[0], 2); v[0] += __shfl_xor(v[0], 1);
        if ((F.lane & 7) == 0) red[F.wave * 8 + (F.lane >> 3)] = v[0];
        __syncthreads();
#pragma unroll
        for (int i = 0; i < 4; ++i) {
            const int ha = is_ctx ? (2 * q) * 8 + i : (vert_wave ? (2 * i) * 8 + q : (2 * q) * 8 + i);
            const int va = is_ctx ? (2 * q + 1) * 8 + i : (vert_wave ? (2 * q + 1) * 8 + i : (2 * i + 1) * 8 + q);
            const float mean = (red[ha] + red[va]) * (1.0f / CDIM), var = (red[ha + 4] + red[va + 4]) * (1.0f / CDIM) - mean * mean;
            const float rstd = 1.0f / sqrtf(fmaxf(var, 0.f) + EPS);
            const f32x4 y0 = (o[i][0] - mean) * rstd * g2[0] + b2[0], y1 = (o[i][1] - mean) * rstd * g2[1] + b2[1];
            const int tok = is_ctx ? tokc + 4 * q + i : (vert_wave ? bb * SEQ + (r0 + i) * 64 + w0 + q : bb * SEQ + (r0 + q) * 64 + w0 + i);
            pg8::u32x4 w; w.x = pkbf(y0[0] * sigm(y0[0]), y0[1] * sigm(y0[1])); w.y = pkbf(y0[2] * sigm(y0[2]), y0[3] * sigm(y0[3]));
            w.z = pkbf(y1[0] * sigm(y1[0]), y1[1] * sigm(y1[1])); w.w = pkbf(y1[2] * sigm(y1[2]), y1[3] * sigm(y1[3]));
            *(pg8::u32x4*)(CONVACT + (size_t)tok * CDIM + ch) = w;
        }
        __syncthreads();
    }
    __syncthreads();
}

constexpr int SSM_CH = 288, SSM_NBLK = 18;
__device__ __forceinline__ int ssm_row(int b, int q, int d, int i) {
    const int s = q * SSM_CH + i;
    return s < CTXL ? ML + b * CTXL + (d ? CTXL - 1 - s : s) : b * SEQ + (d ? SEQ - 1 - (s - CTXL) : s - CTXL);
}
constexpr int SSM_RS = 272;
template <bool PASS2>
__device__ __forceinline__ void ssm_task(const Frame& F, int l, int d, int bp, int g, int q, const bf16* SSMIN, f32x2* E, float* Y) {
    const unsigned char* ws = F.ws;
    const int lane = F.lane, jj = lane & 31, half = lane >> 5, ldg = (l * 2 + d) * 64 + g;
    const f32x2* LAM = (const f32x2*)(ws + WS_LAM) + (size_t)ldg * 64;
    const f32x2 lam0 = LAM[jj], lam1 = LAM[32 + jj];
    pg8::bf16x8 bfr[4];
    { const pg8::bf16x8* bop = (const pg8::bf16x8*)(ws + WS_BOP) + (size_t)ldg * 4 * 64 + lane;
#pragma unroll
      for (int nb = 0; nb < 4; ++nb) bfr[nb] = bop[nb * 64]; }
    pg8::bf16x8 cfr[4];
    if (PASS2) { const pg8::bf16x8* cop = (const pg8::bf16x8*)(ws + WS_COP) + (size_t)ldg * 4 * 64 + lane;
#pragma unroll
      for (int ks = 0; ks < 4; ++ks) cfr[ks] = cop[ks * 64]; }
    float h0r = 0.f, h0i = 0.f, h1r = 0.f, h1i = 0.f;
    const int b = 2 * bp + half;
    f32x2* Eb = E + ((size_t)((d * 4 + b) * 64 + g) * 9) * 64;
    if (PASS2) {
        const f32x2* LAMT = (const f32x2*)(ws + WS_LAMT) + (size_t)ldg * 64;
        const f32x2 t0 = LAMT[jj], t1 = LAMT[32 + jj];
        f32x2 e0[7], e1[7];
#pragma unroll
        for (int qq = 0; qq < 7; ++qq) { const int qc = qq < q ? qq : 0; e0[qq] = Eb[qc * 64 + jj]; e1[qq] = Eb[qc * 64 + 32 + jj]; }
#pragma unroll
        for (int qq = 0; qq < 7; ++qq) if (qq < q) {
            const float n0r = t0.x * h0r - t0.y * h0i + e0[qq].x, n0i = t0.x * h0i + t0.y * h0r + e0[qq].y; h0r = n0r; h0i = n0i;
            const float n1r = t1.x * h1r - t1.y * h1i + e1[qq].x, n1i = t1.x * h1i + t1.y * h1r + e1[qq].y; h1r = n1r; h1i = n1i;
        }
    }
    const int iA = lane & 31, halfA = (iA >> 2) & 1, vA = 4 * (iA >> 3) + (iA & 3), bA = 2 * bp + halfA;
    const bf16* ucol = SSMIN + g * 16 + 8 * (lane >> 5);
    LAS unsigned char* img = F.lds + RING_OFF + F.wave * (32 * SSM_RS);
    pg8::bf16x8 a_nxt = *(const pg8::bf16x8*)(ucol + (size_t)ssm_row(bA, q, d, vA) * SDIM);
    for (int blk = 0; blk < SSM_NBLK; ++blk) {
        const pg8::bf16x8 a = a_nxt;
        if (blk + 1 < SSM_NBLK) a_nxt = *(const pg8::bf16x8*)(ucol + (size_t)ssm_row(bA, q, d, (blk + 1) * 16 + vA) * SDIM);
        f32x16 acc[4];
#pragma unroll
        for (int nb = 0; nb < 4; ++nb) { f32x16 z;
#pragma unroll
            for (int e = 0; e < 16; ++e) z[e] = 0.f;
            acc[nb] = __builtin_amdgcn_mfma_f32_32x32x16_bf16(a, bfr[nb], z, 0, 0, 0); }
#pragma unroll
        for (int v = 0; v < 16; ++v) {
            const float n0r = lam0.x * h0r - lam0.y * h0i + acc[0][v], n0i = lam0.x * h0i + lam0.y * h0r + acc[2][v]; h0r = n0r; h0i = n0i;
            const float n1r = lam1.x * h1r - lam1.y * h1i + acc[1][v], n1i = lam1.x * h1i + lam1.y * h1r + acc[3][v]; h1r = n1r; h1i = n1i;
            if (PASS2) { u32x2 w; w.x = pkbf(h0r, h0i); w.y = pkbf(h1r, h1i); *(LAS u32x2*)(img + (half * 16 + v) * SSM_RS + 8 * jj) = w; }
        }
        if (PASS2) {
            LDS_WAIT(); asm volatile("" ::: "memory");
            pg8::f32x4 yacc[2];
#pragma unroll
            for (int tb = 0; tb < 2; ++tb) { yacc[tb] = (pg8::f32x4){0.f, 0.f, 0.f, 0.f};
#pragma unroll
                for (int ks = 0; ks < 4; ++ks) { const pg8::bf16x8 af = *(const LAS pg8::bf16x8*)(img + (tb * 16 + (lane & 15)) * SSM_RS + (32 * ks + 8 * (lane >> 4)) * 2);
                    yacc[tb] = __builtin_amdgcn_mfma_f32_16x16x32_bf16(cfr[ks], af, yacc[tb], 0, 0, 0); } }
            LDS_WAIT(); asm volatile("" ::: "memory");
            const int tk = lane & 15, q4 = lane >> 4;
#pragma unroll
            for (int tb = 0; tb < 2; ++tb) *(pg8::f32x4*)(Y + (size_t)ssm_row(2 * bp + tb, q, d, blk * 16 + tk) * SDIM + g * 16 + 4 * q4) = yacc[tb];
        }
    }
    if (!PASS2) { Eb[q * 64 + jj] = (f32x2){h0r, h0i}; Eb[q * 64 + 32 + jj] = (f32x2){h1r, h1i}; }
}
template <bool PASS2>
__device__ __forceinline__ void phase_ssm(const Frame& F0, int l, const bf16* SSMIN, f32x2* E, float* YF, float* YB, int q_lo, int q_hi) {
    const Frame F = refresh(F0);
    const int gw = F.vcu * NWAVES + F.wave, NGW = F.G * NWAVES, nq = q_hi - q_lo;
    for (int t = gw; t < 256 * nq; t += NGW) {
        const int d = t & 1, bp = (t >> 1) & 1, g = (t >> 2) & 63, q = q_lo + (t >> 8);
        ssm_task<PASS2>(F, l, d, bp, g, q, SSMIN, E, d ? YB : YF);
    }
}
__device__ __forceinline__ void phase_ssm_post(const Frame& F0, const float* YF, const float* YB, const bf16* SSMIN, const float* ssm_d, bf16* SSMACT, int nrows) {
    const Frame F = refresh(F0);
    const size_t n8 = (size_t)nrows * SDIM / 8;
    for (size_t i = (size_t)F.vcu * (NWAVES * 64) + F.tid; i < n8; i += (size_t)F.G * NWAVES * 64) {
        const size_t e = i * 8; const int c = (int)(e & (SDIM - 1));
        const pg8::f32x4 f0 = *(const pg8::f32x4*)(YF + e), f1 = *(const pg8::f32x4*)(YF + e + 4), b0 = *(const pg8::f32x4*)(YB + e), b1 = *(const pg8::f32x4*)(YB + e + 4);
        const pg8::f32x4 d0 = *(const pg8::f32x4*)(ssm_d + c), d1 = *(const pg8::f32x4*)(ssm_d + c + 4);
        const pg8::u32x4 uw = *(const pg8::u32x4*)(SSMIN + e);
        const pg8::f32x4 y0 = f0 + b0 + d0 * pg8::bf4_lo(uw, 0), y1 = f1 + b1 + d1 * pg8::bf4_lo(uw, 1);
        pg8::u32x4 w; w.x = pkbf(gelu_tanh(y0[0]), gelu_tanh(y0[1])); w.y = pkbf(gelu_tanh(y0[2]), gelu_tanh(y0[3])); w.z = pkbf(gelu_tanh(y1[0]), gelu_tanh(y1[1])); w.w = pkbf(gelu_tanh(y1[2]), gelu_tanh(y1[3]));
        *(pg8::u32x4*)(SSMACT + e) = w;
    }
}

constexpr int PH_PER_LAYER = 14, PH_FINAL = 1 + 2 * PH_PER_LAYER, NPHASES = PH_FINAL + 1;
__global__ void __launch_bounds__(NWAVES * 64, 2) fwd_kernel(Args args) {
    extern __shared__ __attribute__((aligned(16))) unsigned char lds[];
    Frame F;
    F.lds = (LAS unsigned char*)lds;
    F.tid = threadIdx.x; F.lane = F.tid & 63; F.wave = __builtin_amdgcn_readfirstlane(F.tid >> 6);
    F.G = gridDim.x; { const int bx = blockIdx.x; F.vcu = (F.G % 8 == 0) ? (bx % 8) * (F.G / 8) + bx / 8 : bx; }
    F.ws = args.ws;
    unsigned char* ws = args.ws;
    gu32* ctl = (gu32*)(ws + WS_CTL);
    volatile LAS unsigned* MISC = (volatile LAS unsigned*)(F.lds + MISC_OFF);
    for (int u = F.tid; u < (LDS_BYTES - LDSCTL_OFF) / 4; u += NWAVES * 64) ((LAS unsigned*)(F.lds + LDSCTL_OFF))[u] = 0u;
    __syncthreads();
    const int lo = args.ph_lo, hi = args.ph_hi;
    XcdBarrier bar; bar.bar = (unsigned*)(ctl + CW_BAR); bar.x = 0; bar.st = nullptr;
    if (hi - lo > 1) bar = xcd_barrier_post((unsigned*)(ctl + CW_BAR), MISC + 8);
#ifndef PHMASK
#define PHMASK 0xFFFFFFFFu
#endif
#define PHON(s) (((PHMASK) >> (s)) & 1u)
#define IN(k) (lo <= (k) && (k) < hi)
#define SEAM(k) do { if (IN((k) + 1)) xcd_barrier(bar); } while (0)

    float* MOD = (float*)(ws + WS_MOD);
    float* X = (float*)(ws + WS_X); bf16* H = (bf16*)(ws + WS_H); bf16* ACT = (bf16*)(ws + WS_ACT);
    bf16* UCONV = (bf16*)(ws + WS_UCONV); bf16* SSMIN = (bf16*)(ws + WS_SSMIN); bf16* GATES = (bf16*)(ws + WS_GATES);
    bf16* CONVACT = (bf16*)(ws + WS_CONVACT); bf16* SSMACT = (bf16*)(ws + WS_SSMACT);
    float* YF = (float*)(ws + WS_YF); float* YB = (float*)(ws + WS_YB); bf16* T1 = (bf16*)(ws + WS_T1); bf16* MIX = (bf16*)(ws + WS_MIX); f32x2* E = (f32x2*)(ws + WS_E); float* SLAB = (float*)(ws + WS_SLAB);

    float* DUMMY = (float*)(ws + WS_END);
    if (PHON(14) && IN(0)) { phase_prologue(F, args); SEAM(0); }

    for (int l = 0; l < 2; ++l) {
        const int pb = 1 + PH_PER_LAYER * l;
        const bool last = (l == 1);
        unsigned char* wl = ws + WS_W + (size_t)l * W_LAYER;
        const float* modl = MOD + (size_t)l * 5 * MODW;
        const float* x_lat = l == 0 ? args.in[0] : X; const float* x_ctx = l == 0 ? args.in[2] : X + (size_t)ML * DM;
        float* Xc = X + (size_t)ML * DM;
        if (PHON(0) && IN(pb + 0)) REP(0) { phase_norm(F, x_lat, x_ctx, args.in[6] + (size_t)l * DM, modl + 0 * DM, H, MT, SLAB, l == 0 ? 0 : 4, MOD + 8 * DM, 0.5f, Xc); SEAM(pb + 0); }
        if (PHON(1) && IN(pb + 1)) REP(1) { pg8::Gemm g{H, (const bf16*)(wl + WO_UP1), MT, 2 * DFF, DM}; pg8::Order S; S.init(MT, 2 * DFF, g.K, F.G, (int)blockIdx.x);
            pg8::EpiSwiGLU Ep{ACT, DFF}; pg8::gemm_phase<pg8::EpiSwiGLU, pg8::Order, true, true>(F.lds + RING_OFF, g, S, Ep); SEAM(pb + 1); }
        if (PHON(2) && IN(pb + 2)) REP(2) { pg8::Gemm g{ACT, (const bf16*)(wl + WO_DN1), MT, DM, DFF}; pg8::Order S; S.init(ML, DM, g.K, F.G, (int)blockIdx.x); S.extra(32, 32, 0, 8, 4);
            pg8::EpiResid Ep{x_lat, x_ctx, rep_ ? DUMMY : X, modl + 2 * DM, 0.5f, rep_ ? DUMMY : SLAB, DFF / 64}; pg8::gemm_phase<pg8::EpiResid, pg8::Order, true, true>(F.lds + RING_OFF, g, S, Ep); SEAM(pb + 2); }
        if (PHON(3) && IN(pb + 3)) REP(3) { phase_norm(F, X, x_ctx, args.in[9] + (size_t)l * DM, modl + 3 * DM, H, MT, SLAB, 4, modl + 2 * DM, 0.5f, Xc); SEAM(pb + 3); }
        if (PHON(4) && IN(pb + 4)) REP(4) { pg8::Gemm g{H, (const bf16*)(wl + WO_IN), MT, NIN, DM}; pg8::Order S;
            if (!last) S.init(MT, NIN, g.K, F.G, (int)blockIdx.x); else { S.init(ML, NIN, g.K, F.G, (int)blockIdx.x); S.extra(16, 32, 8, 4, 1); }
            pg8::EpiProj Ep{UCONV, SSMIN, GATES, args.in[11] + (size_t)l * NIN}; pg8::gemm_phase<pg8::EpiProj, pg8::Order, true, true>(F.lds + RING_OFF, g, S, Ep); SEAM(pb + 4); }
        if (PHON(5) && IN(pb + 5)) REP(5) {
            phase_conv(F, UCONV, args.in[12] + (size_t)l * CONVK * CDIM, args.in[13] + (size_t)l * CDIM, args.in[14] + (size_t)l * CDIM, args.in[15] + (size_t)l * CDIM, CONVACT, last ? 512 : 576);
            phase_ssm<false>(F, l, SSMIN, E, YF, YB, 0, 7);
            SEAM(pb + 5); }
        if (PHON(6) && IN(pb + 6)) REP(6) { phase_ssm<true>(F, l, SSMIN, E, YF, YB, 0, 8); SEAM(pb + 6); }
        if (PHON(7) && IN(pb + 7)) REP(7) { phase_ssm_post(F, YF, YB, SSMIN, args.in[24] + (size_t)l * SDIM, SSMACT, last ? ML : MT); SEAM(pb + 7); }
        const int Mx = last ? ML : MT;
        if (PHON(8) && IN(pb + 8)) REP(8) { pg8::Gemm g{SSMACT, (const bf16*)(wl + WO_GLU), Mx, 2 * DM, SDIM}; pg8::Order S; S.init(Mx, 2 * DM, g.K, F.G, (int)blockIdx.x);
            pg8::EpiGluGate Ep{T1, GATES, args.in[26] + (size_t)l * 2 * DM}; pg8::gemm_phase<pg8::EpiGluGate, pg8::Order, true, true>(F.lds + RING_OFF, g, S, Ep); SEAM(pb + 8); }
        if (PHON(9) && IN(pb + 9)) REP(9) { pg8::Gemm g{CONVACT, (const bf16*)(wl + WO_CO), Mx, DM, CDIM}; pg8::Order S; S.init(Mx, DM, g.K, F.G, (int)blockIdx.x);
            pg8::EpiConvMix Ep{MIX, GATES, T1}; pg8::gemm_phase<pg8::EpiConvMix, pg8::Order, true, true>(F.lds + RING_OFF, g, S, Ep); SEAM(pb + 9); }
        if (PHON(10) && IN(pb + 10)) REP(10) { pg8::Gemm g{MIX, (const bf16*)(wl + WO_OUT), Mx, DM, DM}; pg8::Order S; S.init(ML, DM, g.K, F.G, (int)blockIdx.x); if (!last) S.extra(32, 32, 0, 8, 8);
            pg8::EpiResid Ep{X, Xc, rep_ ? DUMMY : X, modl + 5 * DM, 1.0f, rep_ ? DUMMY : SLAB, DM / 64}; pg8::gemm_phase<pg8::EpiResid, pg8::Order, true, true>(F.lds + RING_OFF, g, S, Ep); SEAM(pb + 10); }
        if (PHON(11) && IN(pb + 11)) REP(11) { phase_norm(F, X, Xc, args.in[28] + (size_t)l * DM, modl + 6 * DM, H, Mx, SLAB, last ? 0 : 8, modl + 5 * DM, 1.0f, Xc); SEAM(pb + 11); }
        if (PHON(12) && IN(pb + 12)) REP(12) { pg8::Gemm g{H, (const bf16*)(wl + WO_UP2), Mx, 2 * DFF, DM}; pg8::Order S; S.init(Mx, 2 * DFF, g.K, F.G, (int)blockIdx.x);
            pg8::EpiSwiGLU Ep{ACT, DFF}; pg8::gemm_phase<pg8::EpiSwiGLU, pg8::Order, true, true>(F.lds + RING_OFF, g, S, Ep); SEAM(pb + 12); }
        if (PHON(13) && IN(pb + 13)) REP(13) { pg8::Gemm g{ACT, (const bf16*)(wl + WO_DN2), Mx, DM, DFF}; pg8::Order S; S.init(ML, DM, g.K, F.G, (int)blockIdx.x); if (!last) S.extra(32, 32, 0, 8, 4);
            pg8::EpiResid Ep{X, Xc, rep_ ? DUMMY : X, modl + 8 * DM, 0.5f, rep_ ? DUMMY : SLAB, DFF / 64}; pg8::gemm_phase<pg8::EpiResid, pg8::Order, true, true>(F.lds + RING_OFF, g, S, Ep); SEAM(pb + 13); }
    }
    if (PHON(15) && IN(PH_FINAL)) phase_final(F, X, args.in[31], args.out);
#undef IN
#undef SEAM
}

extern "C" void kernel_launch(void* const* d_in, const int* in_sizes, int n_in, void* d_out, int out_size, void* d_ws, size_t ws_size, hipStream_t stream) {
    static int grid = 0;
    if (grid == 0) {
        if (n_in != 32 || in_sizes[0] != ML * DM || out_size != ML * DM || ws_size < WS_END) { fprintf(stderr, "kernel_launch: unexpected shapes (n_in %d, in0 %d, out %d, ws %zu); nothing launched\n", n_in, n_in > 0 ? in_sizes[0] : -1, out_size, ws_size); grid = -1; return; }
        int dev = 0, cus = 0, per_cu = 0;
        if (hipGetDevice(&dev) != hipSuccess || hipDeviceGetAttribute(&cus, hipDeviceAttributeMultiprocessorCount, dev) != hipSuccess) { grid = -1; return; }
        if (hipFuncSetAttribute((const void*)fwd_kernel, hipFuncAttributeMaxDynamicSharedMemorySize, LDS_BYTES) != hipSuccess) { fprintf(stderr, "kernel_launch: hipFuncSetAttribute failed\n"); grid = -1; return; }
        if (hipOccupancyMaxActiveBlocksPerMultiprocessor(&per_cu, (const void*)fwd_kernel, NWAVES * 64, LDS_BYTES) != hipSuccess || per_cu < 1) fprintf(stderr, "kernel_launch: occupancy query reports %d blocks per CU\n", per_cu);
        (void)hipGetLastError();
        grid = cus;
    }
    if (grid < 0) return;
    if (hipMemsetAsync((char*)d_ws + WS_CTL, 0, ZERO_BYTES, stream) != hipSuccess) { fprintf(stderr, "kernel_launch: memset failed\n"); return; }
    Args a{};
    for (int i = 0; i < 32; ++i) a.in[i] = (const float*)d_in[i];
    a.out = (float*)d_out; a.ws = (unsigned char*)d_ws;
#if MK_PER_PHASE
    for (int p = 0; p < NPHASES; ++p) { a.ph_lo = p; a.ph_hi = p + 1; hipLaunchKernelGGL(fwd_kernel, dim3(grid), dim3(NWAVES * 64), LDS_BYTES, stream, a); }
#else
    a.ph_lo = 0; a.ph_hi = NPHASES; hipLaunchKernelGGL(fwd_kernel, dim3(grid), dim3(NWAVES * 64), LDS_BYTES, stream, a);
#endif
    const hipError_t le = hipPeekAtLastError();
    if (le != hipSuccess) fprintf(stderr, "kernel_launch: launch failed: %s\n", hipGetErrorName(le));
}
```

```cpp
#include <hip/hip_runtime.h>
#include <cstdio>
#include <cstdint>
namespace pg8 {
#define PG8_LAS __attribute__((address_space(3)))
typedef unsigned short bf16_t;
typedef short bf16x8 __attribute__((ext_vector_type(8)));
typedef float f32x4 __attribute__((ext_vector_type(4)));
typedef unsigned u32x4 __attribute__((ext_vector_type(4)));
constexpr int BM = 256, BK = 64, HALF = 128, HTB = HALF * BK * 2  , STAGE_BYTES = 8 * HTB, NXCD = 8, WGM = 8;

__host__ __device__ __forceinline__ int lds_byte(int r, int c) { const int st = (r >> 4) * 2 + (c >> 5), rr = r & 15, cc = c & 31, ob = rr * 64 + cc * 2; return st * 1024 + (ob ^ (((ob >> 9) & 1) << 5)); }
__host__ __device__ __forceinline__ void stage_rc(int b, int& R, int& C) { const int st = b / 1024, sb = b % 1024, swz = sb ^ (((sb >> 9) & 1) << 5); R = (st >> 1) * 16 + swz / 64; C = (st & 1) * 32 + (swz % 64) / 2; }
__host__ __device__ __forceinline__ int perm32(int rho) { const int n = rho >> 4, i = rho & 15; return 8 * (i >> 2) + 4 * n + (i & 3); }

struct Unit { int pm, pn, k0, nt; };
struct Gemm { const bf16_t* A; const bf16_t* Bt; int M, N, K; };

__device__ __forceinline__ unsigned cvt_pk_bf16(float lo, float hi) { unsigned r; asm volatile("v_cvt_pk_bf16_f32 %0, %1, %2" : "=v"(r) : "v"(lo), "v"(hi)); return r; }
struct Order {
    int nM, nN, nwg, G, c, ntK, ex_n, ex_pm0, ex_pn0, ex_w, ex_split;
    __device__ __forceinline__ void init(int M, int N, int K, int G_, int c_) { nM = M / BM; nN = N / BM; nwg = nM * nN; G = G_; c = c_; ntK = K / BK; ex_n = 0; ex_pm0 = 0; ex_pn0 = 0; ex_w = 1; ex_split = 1; }
    __device__ __forceinline__ void extra(int n_units, int pm0, int pn0, int w, int split) { ex_n = n_units * split; ex_pm0 = pm0; ex_pn0 = pn0; ex_w = w; ex_split = split; }
    __device__ __forceinline__ bool next(int i, Unit& u) const {
        const long L = (long)i * G + c;
        const bool is_main = L < nwg;
        const int e = is_main ? 0 : (int)(L - nwg);
        const bool ok = is_main || e < ex_n;
        int wgid = is_main ? (int)L : 0; { const int q = nwg / NXCD, r = nwg % NXCD, xcd = wgid % NXCD, off = wgid / NXCD; wgid = (xcd < r ? xcd * (q + 1) : r * (q + 1) + (xcd - r) * q) + off; }
        const int nig = WGM * nN, gid = wgid / nig, fm = gid * WGM, gsz = (nM - fm) < WGM ? (nM - fm) : WGM;
        const int pm_m = fm + ((wgid % nig) % gsz), pn_m = (wgid % nig) / gsz;
        const int piece = e % ex_split, ue = e / ex_split, ntp = ntK / ex_split;
        const int pm_e = ex_pm0 + ue / ex_w, pn_e = ex_pn0 + ue % ex_w;
        Unit r; r.pm = is_main ? pm_m : pm_e; r.pn = is_main ? pn_m : pn_e; r.k0 = is_main ? 0 : piece * ntp; r.nt = is_main ? ntK : ntp;
        u = r; return ok;
    }
    __device__ __forceinline__ void a_ready(const Unit&) const {}
    __device__ __forceinline__ void done(const Unit&) const {}
};

__device__ __forceinline__ float fsigmoid(float x) { return __builtin_amdgcn_rcpf(1.0f + __expf(-x)); }
__device__ __forceinline__ float fsilu(float x) { return x * fsigmoid(x); }
__device__ __forceinline__ f32x4 bf4_lo(u32x4 w, int half) {
    const unsigned a = half ? w.z : w.x, b = half ? w.w : w.y;
    return (f32x4){__uint_as_float(a << 16), __uint_as_float(a & 0xffff0000u), __uint_as_float(b << 16), __uint_as_float(b & 0xffff0000u)};
}

struct EpiSwiGLU {
    static constexpr bool PERM = true, AFTER_DRAIN = false;
    bf16_t* O; int ldc;
    __device__ __forceinline__ void operator()(const f32x4 (&acc)[2][2][4][2], const Unit& u, int wr, int wc, int fr, int fq) const {
        const int row0 = u.pm * BM + wr * 64 + fr, col0 = u.pn * HALF + wc * 32 + 8 * fq;
#pragma unroll
        for (int ai = 0; ai < 2; ++ai)
#pragma unroll
            for (int m = 0; m < 4; ++m) {
                bf16_t* rowp = O + (size_t)(row0 + ai * HALF + m * 16) * ldc + col0;
                float r[8];
#pragma unroll
                for (int n = 0; n < 2; ++n)
#pragma unroll
                    for (int j = 0; j < 4; ++j) r[4 * n + j] = fsilu(acc[ai][1][m][n][j]) * acc[ai][0][m][n][j];
                u32x4 w; w.x = cvt_pk_bf16(r[0], r[1]); w.y = cvt_pk_bf16(r[2], r[3]); w.z = cvt_pk_bf16(r[4], r[5]); w.w = cvt_pk_bf16(r[6], r[7]);
                *(u32x4*)rowp = w;
            }
    }
};

struct EpiResid {
    static constexpr bool PERM = false, AFTER_DRAIN = false;
    const float* base_lat; const float* base_ctx; float* out; const float* gate; float scale;
    float* slab; int ntK;
    __device__ __forceinline__ void operator()(const f32x4 (&acc)[2][2][4][2], const Unit& u, int wr, int wc, int fr, int fq) const {
        const int row0 = u.pm * BM + wr * 64 + fr, col0 = u.pn * BM + wc * 32 + 4 * fq;
        if (u.nt != ntK) {
            float* sp = slab + ((size_t)(u.k0 / u.nt) * 1024 + (size_t)(row0 - 8192)) * 2048 + col0;
#pragma unroll
            for (int ai = 0; ai < 2; ++ai)
#pragma unroll
                for (int m = 0; m < 4; ++m)
#pragma unroll
                    for (int bj = 0; bj < 2; ++bj)
#pragma unroll
                        for (int n = 0; n < 2; ++n) *(f32x4*)(sp + (size_t)(ai * HALF + m * 16) * 2048 + bj * HALF + n * 16) = acc[ai][bj][m][n];
            return;
        }
        const int mrow = u.pm < 32 ? (u.pm >> 3) : 4;
        f32x4 gv[2][2];
#pragma unroll
        for (int bj = 0; bj < 2; ++bj)
#pragma unroll
            for (int n = 0; n < 2; ++n) gv[bj][n] = *(const f32x4*)(gate + (size_t)mrow * 18432 + col0 + bj * HALF + n * 16) * scale;
#pragma unroll
        for (int ai = 0; ai < 2; ++ai)
#pragma unroll
            for (int m = 0; m < 4; ++m) {
                const int r = row0 + ai * HALF + m * 16;
                const float* bp = (r < 8192 ? base_lat + (size_t)r * 2048 : base_ctx + (size_t)(r - 8192) * 2048) + col0;
                float* op = out + (size_t)r * 2048 + col0;
#pragma unroll
                for (int bj = 0; bj < 2; ++bj)
#pragma unroll
                    for (int n = 0; n < 2; ++n) *(f32x4*)(op + bj * HALF + n * 16) = *(const f32x4*)(bp + bj * HALF + n * 16) + gv[bj][n] * acc[ai][bj][m][n];
            }
    }
};

struct EpiProj {
    static constexpr bool PERM = true, AFTER_DRAIN = false;
    bf16_t* UCONV; bf16_t* SSMIN; bf16_t* GATES; const float* bias;
    __device__ __forceinline__ void operator()(const f32x4 (&acc)[2][2][4][2], const Unit& u, int wr, int wc, int fr, int fq) const {
        const int row0 = u.pm * BM + wr * 64 + fr, jj = wc * 32 + 8 * fq;
        if (u.pn < 8) {
            const int col0 = u.pn * HALF + jj;
            f32x4 ba[2], bg[2];
#pragma unroll
            for (int n = 0; n < 2; ++n) { ba[n] = *(const f32x4*)(bias + col0 + 4 * n); bg[n] = *(const f32x4*)(bias + 1024 + col0 + 4 * n); }
#pragma unroll
            for (int ai = 0; ai < 2; ++ai)
#pragma unroll
                for (int m = 0; m < 4; ++m) {
                    bf16_t* rowp = UCONV + (size_t)(row0 + ai * HALF + m * 16) * 1024 + col0;
                    float r[8];
#pragma unroll
                    for (int n = 0; n < 2; ++n)
#pragma unroll
                        for (int j = 0; j < 4; ++j) r[4 * n + j] = (acc[ai][0][m][n][j] + ba[n][j]) * fsigmoid(acc[ai][1][m][n][j] + bg[n][j]);
                    u32x4 w; w.x = cvt_pk_bf16(r[0], r[1]); w.y = cvt_pk_bf16(r[2], r[3]); w.z = cvt_pk_bf16(r[4], r[5]); w.w = cvt_pk_bf16(r[6], r[7]);
                    *(u32x4*)rowp = w;
                }
        } else {
            const bool is_gate = u.pn >= 12;
            bf16_t* O = is_gate ? GATES : SSMIN; const int ldc = is_gate ? 4096 : 1024;
            const int col0 = (is_gate ? (u.pn - 12) : (u.pn - 8)) * BM + jj, bcol0 = u.pn * BM + jj;
            f32x4 bv[2][2];
#pragma unroll
            for (int bj = 0; bj < 2; ++bj)
#pragma unroll
                for (int n = 0; n < 2; ++n) bv[bj][n] = *(const f32x4*)(bias + bcol0 + bj * HALF + 4 * n);
#pragma unroll
            for (int ai = 0; ai < 2; ++ai)
#pragma unroll
                for (int m = 0; m < 4; ++m) {
                    bf16_t* rowp = O + (size_t)(row0 + ai * HALF + m * 16) * ldc + col0;
#pragma unroll
                    for (int bj = 0; bj < 2; ++bj) {
                        f32x4 v0 = acc[ai][bj][m][0] + bv[bj][0], v1 = acc[ai][bj][m][1] + bv[bj][1];
                        if (is_gate) {
#pragma unroll
                            for (int j = 0; j < 4; ++j) { v0[j] = fsigmoid(v0[j]); v1[j] = fsigmoid(v1[j]); }
                        }
                        u32x4 w; w.x = cvt_pk_bf16(v0[0], v0[1]); w.y = cvt_pk_bf16(v0[2], v0[3]); w.z = cvt_pk_bf16(v1[0], v1[1]); w.w = cvt_pk_bf16(v1[2], v1[3]);
                        *(u32x4*)(rowp + bj * HALF) = w;
                    }
                }
        }
    }
};

struct EpiGluGate {
    static constexpr bool PERM = true, AFTER_DRAIN = false;
    bf16_t* T1; const bf16_t* GATES; const float* bias;
    __device__ __forceinline__ void operator()(const f32x4 (&acc)[2][2][4][2], const Unit& u, int wr, int wc, int fr, int fq) const {
        const int row0 = u.pm * BM + wr * 64 + fr, col0 = u.pn * HALF + wc * 32 + 8 * fq;
        f32x4 ba[2], bg[2];
#pragma unroll
        for (int n = 0; n < 2; ++n) { ba[n] = *(const f32x4*)(bias + col0 + 4 * n); bg[n] = *(const f32x4*)(bias + 2048 + col0 + 4 * n); }
        u32x4 gwv[2][4];
#pragma unroll
        for (int ai = 0; ai < 2; ++ai)
#pragma unroll
            for (int m = 0; m < 4; ++m) gwv[ai][m] = *(const u32x4*)(GATES + (size_t)(row0 + ai * HALF + m * 16) * 4096 + 2048 + col0);
#pragma unroll
        for (int ai = 0; ai < 2; ++ai)
#pragma unroll
            for (int m = 0; m < 4; ++m) {
                const size_t r = (size_t)(row0 + ai * HALF + m * 16);
                const u32x4 gw = gwv[ai][m];
                float rr[8];
#pragma unroll
                for (int n = 0; n < 2; ++n) { const f32x4 gs = bf4_lo(gw, n);
#pragma unroll
                    for (int j = 0; j < 4; ++j) rr[4 * n + j] = gs[j] * (acc[ai][0][m][n][j] + ba[n][j]) * fsigmoid(acc[ai][1][m][n][j] + bg[n][j]); }
                u32x4 w; w.x = cvt_pk_bf16(rr[0], rr[1]); w.y = cvt_pk_bf16(rr[2], rr[3]); w.z = cvt_pk_bf16(rr[4], rr[5]); w.w = cvt_pk_bf16(rr[6], rr[7]);
                *(u32x4*)(T1 + r * 2048 + col0) = w;
            }
    }
};

struct EpiConvMix {
    static constexpr bool PERM = true, AFTER_DRAIN = false;
    bf16_t* MIX; const bf16_t* GATES; const bf16_t* T1;
    __device__ __forceinline__ void operator()(const f32x4 (&acc)[2][2][4][2], const Unit& u, int wr, int wc, int fr, int fq) const {
        const int row0 = u.pm * BM + wr * 64 + fr, col0 = u.pn * BM + wc * 32 + 8 * fq;
#pragma unroll
        for (int ai = 0; ai < 2; ++ai) {
            u32x4 gwv[4][2], twv[4][2];
#pragma unroll
            for (int m = 0; m < 4; ++m)
#pragma unroll
                for (int bj = 0; bj < 2; ++bj) { const size_t r = (size_t)(row0 + ai * HALF + m * 16);
                    gwv[m][bj] = *(const u32x4*)(GATES + r * 4096 + col0 + bj * HALF); twv[m][bj] = *(const u32x4*)(T1 + r * 2048 + col0 + bj * HALF); }
#pragma unroll
            for (int m = 0; m < 4; ++m) {
                const size_t r = (size_t)(row0 + ai * HALF + m * 16);
#pragma unroll
                for (int bj = 0; bj < 2; ++bj) {
                    const u32x4 gw = gwv[m][bj];
                    const u32x4 tw = twv[m][bj];
                    const f32x4 v0 = bf4_lo(gw, 0) * acc[ai][bj][m][0] + bf4_lo(tw, 0), v1 = bf4_lo(gw, 1) * acc[ai][bj][m][1] + bf4_lo(tw, 1);
                    u32x4 w; w.x = cvt_pk_bf16(v0[0], v0[1]); w.y = cvt_pk_bf16(v0[2], v0[3]); w.z = cvt_pk_bf16(v1[0], v1[1]); w.w = cvt_pk_bf16(v1[2], v1[3]);
                    *(u32x4*)(MIX + r * 2048 + col0 + bj * HALF) = w;
                }
            }
        }
    }
};

template <class Epi, class Sched, bool ALIGN_EPI = false, bool SP2 = false>
__device__ __forceinline__ void gemm_phase(PG8_LAS unsigned char* lds, const Gemm g, const Sched& S, const Epi& E) {
    int tid_ = threadIdx.x; asm volatile("" : "+v"(tid_));
    const int tid = tid_, wid = __builtin_amdgcn_readfirstlane(tid >> 6), lane = tid & 63, wr = wid >> 2, wc = wid & 3, fr = lane & 15, fq = lane >> 4;
    const int K = g.K;
    unsigned voffA[2], voffB[2];
#pragma unroll
    for (int i = 0; i < 2; ++i) { int R, C; stage_rc(tid * 16 + i * 8192, R, C); const int Rb = Epi::PERM ? ((R & ~31) + perm32(R & 31)) : R;
        voffA[i] = (unsigned)(R * K + C) * 2u; voffB[i] = (unsigned)(Rb * BK + C) * 2u; }
    const size_t kstep = (size_t)(BK * 2);
    const size_t kstepB = (size_t)HTB;
    const size_t hstep = (size_t)HALF * K * 2;
    const size_t tstep = 2 * hstep;
    const unsigned ldsw = (unsigned)wid * 1024u;
    const int aoff = lds_byte(wr * 64 + fr, fq * 8), boff = lds_byte(wc * 32 + fr, fq * 8);
#define PG8_SA(b, h) (((b) * 2 + (h)) * HTB)
#define PG8_SB(b, h) ((4 + (b) * 2 + (h)) * HTB)
#define PG8_STAGE(bufoff, gbase, voff) do { _Pragma("unroll") for (int _i = 0; _i < 2; ++_i) \
        __builtin_amdgcn_global_load_lds((const unsigned*)((const char*)(gbase) + (voff)[_i]), (PG8_LAS unsigned*)(lds + (bufoff) + ldsw + _i * 8192), 16, 0, 0); } while (0)
#define PG8_LDA(dst, b, h) do { _Pragma("unroll") for (int m = 0; m < 4; ++m) _Pragma("unroll") for (int k = 0; k < 2; ++k) dst[m][k] = *(const PG8_LAS bf16x8*)(lds + PG8_SA(b, h) + aoff + m * 2048 + k * 1024); } while (0)
#define PG8_LDB(dst, b, h) do { _Pragma("unroll") for (int n = 0; n < 2; ++n) _Pragma("unroll") for (int k = 0; k < 2; ++k) dst[n][k] = *(const PG8_LAS bf16x8*)(lds + PG8_SB(b, h) + boff + n * 2048 + k * 1024); } while (0)
#define PG8_MMA(ai, bj, At, Bt) do { __builtin_amdgcn_s_setprio(1); _Pragma("unroll") for (int m = 0; m < 4; ++m) _Pragma("unroll") for (int n = 0; n < 2; ++n) _Pragma("unroll") for (int k = 0; k < 2; ++k) \
        acc[ai][bj][m][n] = __builtin_amdgcn_mfma_f32_16x16x32_bf16(Bt[n][k], At[m][k], acc[ai][bj][m][n], 0, 0, 0); __builtin_amdgcn_s_setprio(0); } while (0)
#define PG8_WAIT_V(n) asm volatile("s_waitcnt vmcnt(" #n ")" ::: "memory")
#define PG8_WAIT_L(n) asm volatile("s_waitcnt lgkmcnt(" #n ")" ::: "memory")
#define PG8_BAR __builtin_amdgcn_s_barrier()
#define PG8_SCHED __builtin_amdgcn_sched_barrier(0)
    Unit cur, nxt; int ui = 0;
    if (!S.next(0, cur)) return;
    f32x4 acc[2][2][4][2];
#pragma unroll
    for (int a = 0; a < 2; ++a)
#pragma unroll
        for (int b = 0; b < 2; ++b)
#pragma unroll
            for (int m = 0; m < 4; ++m)
#pragma unroll
                for (int n = 0; n < 2; ++n) acc[a][b][m][n] = (f32x4){0.f, 0.f, 0.f, 0.f};
    bf16x8 At[4][2], B0[2][2], B1[2][2];
    const char* cA = (const char*)g.A + (size_t)cur.pm * tstep + (size_t)cur.k0 * kstep; const char* cB = (const char*)g.Bt + (size_t)cur.pn * tstep + (size_t)cur.k0 * kstepB;
    S.a_ready(cur);
    if constexpr (SP2) {
        PG8_STAGE(PG8_SB(0, 0), cB, voffB); PG8_STAGE(PG8_SB(0, 1), cB + hstep, voffB); PG8_STAGE(PG8_SA(0, 0), cA, voffA); PG8_STAGE(PG8_SA(0, 1), cA + hstep, voffA);
        if (wr == 1) PG8_BAR;
        PG8_WAIT_V(2); PG8_BAR;
        PG8_STAGE(PG8_SB(1, 0), cB + kstepB, voffB); PG8_STAGE(PG8_SA(1, 0), cA + kstep, voffA); PG8_STAGE(PG8_SB(1, 1), cB + hstep + kstepB, voffB);
        PG8_WAIT_V(6); PG8_BAR;
    } else {
        PG8_STAGE(PG8_SB(0, 0), cB, voffB); PG8_STAGE(PG8_SA(0, 0), cA, voffA); PG8_STAGE(PG8_SB(0, 1), cB + hstep, voffB); PG8_STAGE(PG8_SA(0, 1), cA + hstep, voffA);
        if (wr == 1) PG8_BAR;
        PG8_WAIT_V(4); PG8_BAR;
        PG8_STAGE(PG8_SB(1, 0), cB + kstepB, voffB); PG8_STAGE(PG8_SA(1, 0), cA + kstep, voffA); PG8_STAGE(PG8_SB(1, 1), cB + hstep + kstepB, voffB);
        PG8_WAIT_V(6); PG8_BAR;
    }
    for (;;) {
        const bool has_next = S.next(ui + 1, nxt);
        const char* nA = has_next ? (const char*)g.A + (size_t)nxt.pm * tstep + (size_t)nxt.k0 * kstep : cA; const char* nB = has_next ? (const char*)g.Bt + (size_t)nxt.pn * tstep + (size_t)nxt.k0 * kstepB : cB;
        const int nt = cur.nt;
        for (int t = 0; t < nt; t += 2) {
            const bool last = (t == nt - 2);
            const char* a1 = cA + (size_t)(t + 1) * kstep;
            const char* a2 = last ? nA : cA + (size_t)(t + 2) * kstep; const char* b2 = last ? nB : cB + (size_t)(t + 2) * kstepB;
            const char* a3 = a2 + kstep; const char* b3 = b2 + kstepB;
            if (last && has_next) S.a_ready(nxt);
            if constexpr (SP2) {
            PG8_LDB(B0, 0, 0); PG8_LDB(B1, 0, 1); PG8_SCHED; PG8_LDA(At, 0, 0); PG8_STAGE(PG8_SA(1, 1), a1 + hstep, voffA);
            PG8_WAIT_V(8); PG8_WAIT_L(0); PG8_BAR; PG8_MMA(0, 0, At, B0); PG8_MMA(0, 1, At, B1); PG8_BAR; PG8_SCHED;
            PG8_LDA(At, 0, 1); PG8_STAGE(PG8_SB(0, 0), b2, voffB); PG8_STAGE(PG8_SB(0, 1), b2 + hstep, voffB); PG8_STAGE(PG8_SA(0, 0), a2, voffA);
            PG8_WAIT_V(8); PG8_WAIT_L(0); PG8_BAR; PG8_MMA(1, 0, At, B0); PG8_MMA(1, 1, At, B1); PG8_BAR; PG8_SCHED;
            PG8_LDB(B0, 1, 0); PG8_LDB(B1, 1, 1); PG8_SCHED; PG8_LDA(At, 1, 0); PG8_STAGE(PG8_SA(0, 1), a2 + hstep, voffA);
            PG8_WAIT_V(8); PG8_WAIT_L(0); PG8_BAR; PG8_MMA(0, 0, At, B0); PG8_MMA(0, 1, At, B1); PG8_BAR; PG8_SCHED;
            PG8_LDA(At, 1, 1); PG8_STAGE(PG8_SB(1, 0), b3, voffB); PG8_STAGE(PG8_SB(1, 1), b3 + hstep, voffB); PG8_STAGE(PG8_SA(1, 0), a3, voffA);
            PG8_WAIT_V(8); PG8_WAIT_L(0); PG8_BAR; PG8_MMA(1, 0, At, B0); PG8_MMA(1, 1, At, B1); PG8_BAR; PG8_SCHED;
            } else {
            PG8_LDB(B0, 0, 0); PG8_SCHED; PG8_LDA(At, 0, 0); PG8_STAGE(PG8_SA(1, 1), a1 + hstep, voffA);
            PG8_WAIT_L(8); PG8_BAR; PG8_WAIT_L(0); PG8_MMA(0, 0, At, B0); PG8_BAR; PG8_SCHED;
            PG8_LDB(B1, 0, 1); PG8_STAGE(PG8_SB(0, 0), b2, voffB);
            PG8_BAR; PG8_WAIT_L(0); PG8_MMA(0, 1, At, B1); PG8_BAR;
            PG8_LDA(At, 0, 1); PG8_STAGE(PG8_SA(0, 0), a2, voffA);
            PG8_BAR; PG8_WAIT_L(0); PG8_MMA(1, 0, At, B0); PG8_BAR; PG8_SCHED;
            PG8_STAGE(PG8_SB(0, 1), b2 + hstep, voffB);
            PG8_WAIT_V(6); PG8_BAR; PG8_MMA(1, 1, At, B1); PG8_BAR;
            PG8_LDB(B0, 1, 0); PG8_SCHED; PG8_LDA(At, 1, 0); PG8_STAGE(PG8_SA(0, 1), a2 + hstep, voffA);
            PG8_WAIT_L(8); PG8_BAR; PG8_WAIT_L(0); PG8_MMA(0, 0, At, B0); PG8_BAR; PG8_SCHED;
            PG8_LDB(B1, 1, 1); PG8_STAGE(PG8_SB(1, 0), b3, voffB);
            PG8_BAR; PG8_WAIT_L(0); PG8_MMA(0, 1, At, B1); PG8_BAR;
            PG8_LDA(At, 1, 1); PG8_STAGE(PG8_SA(1, 0), a3, voffA);
            PG8_BAR; PG8_WAIT_L(0); PG8_MMA(1, 0, At, B0); PG8_BAR; PG8_SCHED;
            PG8_STAGE(PG8_SB(1, 1), b3 + hstep, voffB);
            PG8_WAIT_V(6); PG8_BAR; PG8_MMA(1, 1, At, B1); PG8_BAR;
            }
        }
        if constexpr (ALIGN_EPI) { if (wr == 0) PG8_BAR; }
        if constexpr (!Epi::AFTER_DRAIN) { E(acc, cur, wr, wc, fr, fq); S.done(cur); }
        if (!has_next) break;
#pragma unroll
        for (int a = 0; a < 2; ++a)
#pragma unroll
            for (int b = 0; b < 2; ++b)
#pragma unroll
                for (int m = 0; m < 4; ++m)
#pragma unroll
                    for (int n = 0; n < 2; ++n) acc[a][b][m][n] = (f32x4){0.f, 0.f, 0.f, 0.f};
        cur = nxt; cA = nA; cB = nB; ++ui;
        if constexpr (ALIGN_EPI) { if (wr == 1) PG8_BAR; }
    }
    PG8_WAIT_V(0);
    if constexpr (!ALIGN_EPI) { if (wr == 0) PG8_BAR; }
    PG8_BAR;
    if constexpr (Epi::AFTER_DRAIN) { E.fused(acc, cur, wr, wc, fr, fq, lds, wid, lane); S.done(cur); }
#undef PG8_SA
#undef PG8_SB
#undef PG8_STAGE
#undef PG8_LDA
#undef PG8_LDB
#undef PG8_MMA
#undef PG8_WAIT_V
#undef PG8_WAIT_L
#undef PG8_BAR
#undef PG8_SCHED
}
}
#define GAS __attribute__((address_space(1)))
#define LAS __attribute__((address_space(3)))
typedef unsigned short bf16;
typedef unsigned v4u __attribute__((ext_vector_type(4)));
typedef float f32x4 __attribute__((ext_vector_type(4)));
typedef short bf16x8 __attribute__((ext_vector_type(8)));
typedef GAS unsigned gu32;
typedef GAS unsigned long long gu64;
#define RLX_AGENT __ATOMIC_RELAXED, __HIP_MEMORY_SCOPE_AGENT
#define LDS_WAIT() asm volatile("s_waitcnt lgkmcnt(0)" ::: "memory")
#define VM_WAIT() asm volatile("s_waitcnt vmcnt(0)" ::: "memory")
__device__ __forceinline__ unsigned long long rt() { return __builtin_amdgcn_s_memrealtime(); }
__device__ __forceinline__ unsigned f2bf(float f) { unsigned u = __builtin_bit_cast(unsigned, f); return (u + 0x7fffu + ((u >> 16) & 1u)) >> 16; }
__device__ __forceinline__ unsigned pk2(float lo, float hi) { return f2bf(lo) | (f2bf(hi) << 16); }
#define XB_TMO      128
#define XB_XCNT(j)  (256  + 64 * (j))
#define XB_XSUB(j)  (1280 + 64 * (j))
#define XB_XGEN(j)  (2304 + 64 * (j))
#define XB_TOP      3328
#define XB_TOPGEN   3392
#define XCD_BAR_WORDS 3456
#define XB_SPIN_CAP (1u << 18)

__device__ __forceinline__ unsigned xb_ld(unsigned* p)              { return __hip_atomic_load(p, __ATOMIC_RELAXED, __HIP_MEMORY_SCOPE_AGENT); }
__device__ __forceinline__ unsigned xb_add(unsigned* p, unsigned v) { return __hip_atomic_fetch_add(p, v, __ATOMIC_RELAXED, __HIP_MEMORY_SCOPE_AGENT); }
__device__ __forceinline__ unsigned xb_xcc_id() { return (unsigned)__builtin_amdgcn_s_getreg((3 << 11) | 20) & 0xFu; }
#define XB_SPIN(cond, bar) do { unsigned _sp = 0; while (cond) { __builtin_amdgcn_s_sleep(1); \
    if ((++_sp & 255u) == 0u) { if (xb_ld(&(bar)[XB_TMO])) break; if (_sp > XB_SPIN_CAP) { atomicAdd(&(bar)[XB_TMO], 1u); break; } } } } while (0)

struct XcdBarrier {
    unsigned* bar; unsigned x;
    volatile LAS unsigned* st;
};

__device__ __forceinline__ XcdBarrier xcd_barrier_post(unsigned* bar, volatile LAS unsigned* st) {
    XcdBarrier b; b.bar = bar; b.x = xb_xcc_id(); b.st = st;
    if (threadIdx.x == 0) (void)xb_add(&bar[XB_XCNT(b.x)], 1u);
    return b;
}
__device__ __forceinline__ void xcd_barrier_complete(unsigned* bar, unsigned x, unsigned& nloc, unsigned& nx) {
    const unsigned G = gridDim.x * gridDim.y * gridDim.z;
    unsigned sum, cnt, mine, sp = 0u;
    for (;;) {
        sum = 0u; cnt = 0u; mine = 0u;
#pragma unroll
        for (unsigned j = 0; j < 16; ++j) { const unsigned c = xb_ld(&bar[XB_XCNT(j)]); sum += c; cnt += (c > 0u) ? 1u : 0u; mine = (j == x) ? c : mine; }
        if (sum == G) break;
        __builtin_amdgcn_s_sleep(1);
        if ((++sp & 255u) == 0u) { if (xb_ld(&bar[XB_TMO])) break; if (sp > XB_SPIN_CAP) { atomicAdd(&bar[XB_TMO], 1u); break; } }
    }
    nloc = mine > 0u ? mine : 1u; nx = cnt > 0u ? cnt : 1u;
}

__device__ __forceinline__ void xcd_barrier(const XcdBarrier& b) {
    asm volatile("s_waitcnt vmcnt(0)" ::: "memory");
    __syncthreads();
    if (threadIdx.x == 0) {
        unsigned* bar = b.bar;
        __builtin_amdgcn_s_waitcnt(0);
        unsigned nloc = b.st[0], nx = b.st[1];
        if (nloc == 0u) { xcd_barrier_complete(bar, b.x, nloc, nx); b.st[0] = nloc; b.st[1] = nx; }
        const unsigned old = xb_add(&bar[XB_XSUB(b.x)], 1u);
        const unsigned gen = old / nloc;
        if (old + 1u == (gen + 1u) * nloc) {
            __builtin_amdgcn_fence(__ATOMIC_RELEASE, "agent");
            asm volatile("s_waitcnt vmcnt(0)" ::: "memory");
            const unsigned og = xb_add(&bar[XB_TOP], 1u);
            const unsigned tg = og / nx;
            if (og + 1u == (tg + 1u) * nx) xb_add(&bar[XB_TOPGEN], 1u);
            else XB_SPIN(xb_ld(&bar[XB_TOPGEN]) == tg, bar);
            __builtin_amdgcn_fence(__ATOMIC_ACQUIRE, "agent");
            xb_add(&bar[XB_XGEN(b.x)], 1u);
            asm volatile("s_waitcnt vmcnt(0)" ::: "memory");
        } else {
            XB_SPIN(xb_ld(&bar[XB_XGEN(b.x)]) == gen, bar);
            __builtin_amdgcn_fence(__ATOMIC_ACQUIRE, "agent");
            asm volatile("s_waitcnt vmcnt(0)" ::: "memory");
        }
    }
    __syncthreads();
}
constexpr int NWAVES = 8;
constexpr int DM = 2048, NBATCH = 4, SEQ = 2048, CTXL = 256, DFF = 5632, CDIM = 1024, CONVK = 31, SDIM = 1024, NGRP = 64, NST = 64, NIN = 7168, MODW = 9 * DM;
constexpr int ML = NBATCH * SEQ, MC = NBATCH * CTXL, MT = ML + MC;
constexpr float EPS = 1e-6f;
#ifndef MK_PER_PHASE
#define MK_PER_PHASE 0
#endif

constexpr size_t MiB = 1u << 20;
constexpr size_t WS_CTL = 0, WS_MOD = 1 * MiB, ZERO_BYTES = 2 * MiB;
constexpr size_t WS_LAM = 2 * MiB, WS_LAMT = WS_LAM + 128 * 1024, WS_BOP = 3 * MiB, WS_COP = 4 * MiB;
constexpr size_t WS_W = 6 * MiB, W_LAYER = 180 * MiB;
constexpr size_t WO_UP1 = 0, WO_DN1 = 44 * MiB, WO_IN = 66 * MiB, WO_CO = 94 * MiB, WO_GLU = 98 * MiB, WO_OUT = 106 * MiB, WO_UP2 = 114 * MiB, WO_DN2 = 158 * MiB;
constexpr size_t WS_X = 366 * MiB, WS_H = 438 * MiB, WS_ACT = 474 * MiB, WS_UCONV = 573 * MiB, WS_SSMIN = 591 * MiB, WS_GATES = 609 * MiB, WS_CONVACT = 681 * MiB, WS_SSMACT = 699 * MiB;
constexpr size_t WS_YF = 717 * MiB, WS_YB = 753 * MiB, WS_T1 = 789 * MiB, WS_MIX = 825 * MiB, WS_E = 861 * MiB, WS_SLAB = 864 * MiB, WS_END = 928 * MiB;
constexpr int CW_TMO = 0, CW_BAR = 4096;
constexpr int RING_OFF = 0, RING_BYTES = 131072, LDSCTL_OFF = RING_BYTES, MISC_OFF = LDSCTL_OFF + 320, LDS_BYTES = 147456;

#ifndef REPMASK
#define REPMASK 0u
#endif
#ifndef REPN
#define REPN 2
#endif
#define REP(s) for (int rep_ = 0; rep_ < ((((REPMASK) >> (s)) & 1u) ? REPN : 1); ++rep_)
typedef float f32x2 __attribute__((ext_vector_type(2)));
typedef float f32x16 __attribute__((ext_vector_type(16)));
typedef unsigned u32x2 __attribute__((ext_vector_type(2)));
__device__ __forceinline__ float wave_sum(float v) {
#pragma unroll
    for (int o = 1; o < 64; o <<= 1) v += __shfl_xor(v, o);
    return v;
}
__device__ __forceinline__ unsigned pkbf(float lo, float hi) { return pg8::cvt_pk_bf16(lo, hi); }
__device__ __forceinline__ float bf_lo(unsigned w) { return __uint_as_float(w << 16); }
__device__ __forceinline__ float bf_hi(unsigned w) { return __uint_as_float(w & 0xffff0000u); }
__device__ __forceinline__ float gelu_tanh(float x) {
    const float z = 0.7978845608028654f * (x + 0.044715f * x * x * x);
    const float e = __expf(2.0f * z);
    const float t = 1.0f - 2.0f * __builtin_amdgcn_rcpf(e + 1.0f);
    return 0.5f * x * (1.0f + t);
}
__device__ __forceinline__ float sigm(float x) { return __builtin_amdgcn_rcpf(1.0f + __expf(-x)); }

struct Args { const float* in[32]; float* out; unsigned char* ws; int ph_lo, ph_hi; };

struct Frame {
    LAS unsigned char* lds;
    int tid, lane, wave, vcu, G;
    unsigned char* ws;
};

__device__ __forceinline__ Frame refresh(const Frame& F0) { Frame F = F0; int t = threadIdx.x; asm volatile("" : "+v"(t)); F.tid = t; F.lane = t & 63; F.wave = __builtin_amdgcn_readfirstlane(t >> 6); return F; }
__device__ __forceinline__ void transpose_item(const float* W, int K, int N, bf16* WT, int k0, int n0, int drow0, LAS float* scr, int lane) {
#pragma unroll 8
    for (int i = 0; i < 32; ++i) { const int kk = 2 * i + (lane >> 5); scr[kk * 33 + (lane & 31)] = W[(size_t)(k0 + kk) * N + n0 + (lane & 31)]; }
    LDS_WAIT(); asm volatile("" ::: "memory");
    const int c = lane & 7;
#pragma unroll
    for (int j = 0; j < 4; ++j) { const int n = (lane >> 3) + 8 * j; const LAS float* s = scr + (8 * c) * 33 + n;
        v4u o; o.x = pkbf(s[0 * 33], s[1 * 33]); o.y = pkbf(s[2 * 33], s[3 * 33]); o.z = pkbf(s[4 * 33], s[5 * 33]); o.w = pkbf(s[6 * 33], s[7 * 33]);
        const int dr = drow0 + n;
        *(GAS v4u*)(WT + ((size_t)(dr >> 7) * (K >> 6) + (k0 >> 6)) * 8192 + (size_t)(dr & 127) * 64 + 8 * c) = o; }
    LDS_WAIT(); asm volatile("" ::: "memory");
}
__device__ __forceinline__ int glu_row(int n, int HC) { const int half = n >= HC ? 1 : 0, j = n - half * HC; return (j >> 7) * 256 + half * 128 + (j & 127); }

__device__ __forceinline__ void phase_prologue(const Frame& F0, const Args& args) {
    const Frame F = refresh(F0);
    const int gw = F.vcu * NWAVES + F.wave, NGW = F.G * NWAVES;
    unsigned char* ws = F.ws;
    {
        LAS float* scr = (LAS float*)(F.lds + RING_OFF + F.wave * 16384);
        constexpr int I_UP = (DM / 64) * (2 * DFF / 32), I_DN = (DFF / 64) * (DM / 32), I_IN = (DM / 64) * (NIN / 32), I_CO = (CDIM / 64) * (DM / 32), I_GLU = (SDIM / 64) * (2 * DM / 32), I_OUT = (DM / 64) * (DM / 32);
        constexpr int I_LAYER = 2 * I_UP + 2 * I_DN + I_IN + I_CO + I_GLU + I_OUT;
        REP(14) for (int it = gw; it < 2 * I_LAYER; it += NGW) {
            const int l = it / I_LAYER; int r = it % I_LAYER;
            unsigned char* wl = ws + WS_W + (size_t)l * W_LAYER;
            const float* W; int K, N, kind; bf16* WT;
            if (r < I_UP) { W = args.in[7] + (size_t)l * DM * 2 * DFF; K = DM; N = 2 * DFF; kind = 1; WT = (bf16*)(wl + WO_UP1); }
            else if ((r -= I_UP) < I_DN) { W = args.in[8] + (size_t)l * DFF * DM; K = DFF; N = DM; kind = 0; WT = (bf16*)(wl + WO_DN1); }
            else if ((r -= I_DN) < I_IN) { W = args.in[10] + (size_t)l * DM * NIN; K = DM; N = NIN; kind = 2; WT = (bf16*)(wl + WO_IN); }
            else if ((r -= I_IN) < I_CO) { W = args.in[16] + (size_t)l * CDIM * DM; K = CDIM; N = DM; kind = 0; WT = (bf16*)(wl + WO_CO); }
            else if ((r -= I_CO) < I_GLU) { W = args.in[25] + (size_t)l * SDIM * 2 * DM; K = SDIM; N = 2 * DM; kind = 1; WT = (bf16*)(wl + WO_GLU); }
            else if ((r -= I_GLU) < I_OUT) { W = args.in[27] + (size_t)l * DM * DM; K = DM; N = DM; kind = 0; WT = (bf16*)(wl + WO_OUT); }
            else if ((r -= I_OUT) < I_UP) { W = args.in[29] + (size_t)l * DM * 2 * DFF; K = DM; N = 2 * DFF; kind = 1; WT = (bf16*)(wl + WO_UP2); }
            else { r -= I_UP; W = args.in[30] + (size_t)l * DFF * DM; K = DFF; N = DM; kind = 0; WT = (bf16*)(wl + WO_DN2); }
            const int nblk = N / 32, kb = r / nblk, nb = r % nblk, n0 = 32 * nb;
            int drow0 = n0;
            if (kind == 1) drow0 = glu_row(n0, N / 2);
            else if (kind == 2 && n0 < 2048) drow0 = glu_row(n0, 1024);
            transpose_item(W, K, N, WT, 64 * kb, n0, drow0, scr, F.lane);
        }
    }
    __syncthreads();
    {
        LAS float* sc = (LAS float*)(F.lds + RING_OFF);
        const float* c = args.in[1]; const float* cc = args.in[3];
        for (int i = F.tid; i < 5 * DM; i += NWAVES * 64) { const float v = i < 4 * DM ? c[i] : cc[i - 4 * DM]; sc[i] = v * sigm(v); }
        __syncthreads();
        const float* ada_w = args.in[4]; const float* ada_b = args.in[5];
        float* MOD = (float*)(ws + WS_MOD);
        for (int it = F.vcu; it < 2 * 7 * 18; it += F.G) {
            const int l = it / 126, kc = (it % 126) / 18, cbk = it % 18, n0 = cbk * 1024 + 4 * (F.tid & 255), rsub = F.tid >> 8;
            const int kbeg = kc * 293, kend = kbeg + 293 < DM ? kbeg + 293 : DM;
            const float* wp = ada_w + (size_t)l * DM * MODW + n0;
            f32x4 a0 = {0.f, 0.f, 0.f, 0.f}, a1 = a0, a2 = a0, a3 = a0, a4 = a0;
            f32x4 wn[16];
#pragma unroll
            for (int j = 0; j < 16; ++j) { const int k = kbeg + rsub + 2 * j < kend ? kbeg + rsub + 2 * j : kend - 1; wn[j] = *(const f32x4*)(wp + (size_t)k * MODW); }
            for (int k0 = kbeg + rsub; k0 < kend; k0 += 32) {
                f32x4 w[16];
#pragma unroll
                for (int j = 0; j < 16; ++j) w[j] = wn[j];
                if (k0 + 32 < kend) {
#pragma unroll
                    for (int j = 0; j < 16; ++j) { const int k = k0 + 32 + 2 * j < kend ? k0 + 32 + 2 * j : kend - 1; wn[j] = *(const f32x4*)(wp + (size_t)k * MODW); } }
#pragma unroll
                for (int j = 0; j < 16; ++j) { const bool ok = k0 + 2 * j < kend; const int k = ok ? k0 + 2 * j : kend - 1; const f32x4 wv = w[j] * (ok ? 1.f : 0.f);
                    a0 += wv * sc[k]; a1 += wv * sc[DM + k]; a2 += wv * sc[2 * DM + k]; a3 += wv * sc[3 * DM + k]; a4 += wv * sc[4 * DM + k]; }
            }
            LAS float* part = sc + 5 * DM;
            { LAS float* pp = part + rsub * 5 * 1024 + 4 * (F.tid & 255);
              *(LAS f32x4*)(pp) = a0; *(LAS f32x4*)(pp + 1024) = a1; *(LAS f32x4*)(pp + 2048) = a2; *(LAS f32x4*)(pp + 3072) = a3; *(LAS f32x4*)(pp + 4096) = a4; }
            __syncthreads();
            float* mp = MOD + (size_t)l * 5 * MODW + cbk * 1024;
#pragma unroll
            for (int e = 0; e < 10; ++e) { const int idx = e * 512 + F.tid, r = idx >> 10, cidx = idx & 1023;
                float v = part[idx] + part[5 * 1024 + idx];
                if (kc == 0) v += ada_b[(size_t)l * MODW + cbk * 1024 + cidx];
                atomicAdd(mp + (size_t)r * MODW + cidx, v); }
            __syncthreads();
        }
        __syncthreads();
    }
    {
        f32x2* LAM = (f32x2*)(ws + WS_LAM); f32x2* LAMT = (f32x2*)(ws + WS_LAMT); bf16* BOP = (bf16*)(ws + WS_BOP); bf16* COP = (bf16*)(ws + WS_COP);
        const float *a_re = args.in[17], *a_im = args.in[18], *log_dt = args.in[19], *b_re = args.in[20], *b_im = args.in[21], *c_re = args.in[22], *c_im = args.in[23];
        for (int item = F.vcu * (NWAVES * 64) + F.tid; item < 2 * 2 * NGRP * NST * 16; item += F.G * NWAVES * 64) {
            const int it = item >> 4, c = item & 15;
            const int p = it & 63, ldg = it >> 6;
            const float ar = a_re[it], ai = a_im[it], dt = expf(log_dt[ldg]);
            const float er = expf(ar * dt), lr = er * cosf(ai * dt), li = er * sinf(ai * dt);
            if (c == 0) {
                LAM[it] = (f32x2){lr, li};
                float tr = lr, ti = li;
#pragma unroll
                for (int s = 0; s < 5; ++s) { const float nr = tr * tr - ti * ti, ni = 2.f * tr * ti; tr = nr; ti = ni; }
                const float t32r = tr, t32i = ti;
#pragma unroll
                for (int s = 0; s < 3; ++s) { const float nr = tr * tr - ti * ti, ni = 2.f * tr * ti; tr = nr; ti = ni; }
                LAMT[it] = (f32x2){tr * t32r - ti * t32i, tr * t32i + ti * t32r};
            }
            const float nr = lr - 1.f, ni = li, den = 1.f / (ar * ar + ai * ai);
            const float cr = (nr * ar + ni * ai) * den, ci = (ni * ar - nr * ai) * den;
            const int jj = p & 31, hi = p >> 5;
            const float br = b_re[(size_t)it * 16 + c], bi = b_im[(size_t)it * 16 + c];
            const float vr = cr * br - ci * bi, vi = cr * bi + ci * br;
            const int lane = jj + 32 * (c >> 3), j = c & 7;
            BOP[(((size_t)ldg * 4 + (hi ? 1 : 0)) * 64 + lane) * 8 + j] = (bf16)(pkbf(vr, 0.f) & 0xffffu);
            BOP[(((size_t)ldg * 4 + (hi ? 3 : 2)) * 64 + lane) * 8 + j] = (bf16)(pkbf(vi, 0.f) & 0xffffu);
            const float cre = c_re[((size_t)ldg * 16 + c) * 64 + p], cim = c_im[((size_t)ldg * 16 + c) * 64 + p];
            const int kk = 4 * jj + (hi ? 2 : 0);
            const int ks = kk >> 5, q = (kk & 31) >> 3, j2 = kk & 7, lane2 = c + 16 * q;
            COP[(((size_t)ldg * 4 + ks) * 64 + lane2) * 8 + j2] = (bf16)(pkbf(cre, 0.f) & 0xffffu);
            COP[(((size_t)ldg * 4 + ks) * 64 + lane2) * 8 + j2 + 1] = (bf16)(pkbf(-cim, 0.f) & 0xffffu);
        }
    }
}

template <int NSLAB>
__device__ __forceinline__ void phase_norm_t(const Frame& F0, const float* src_lat, const float* src_ctx, const float* gain, const float* mod, bf16* H, int nrows,
                                             const float* slab, const float* gate, float gscale, float* Xc_out) {
    const Frame F = refresh(F0);
    const int gw = F.vcu * NWAVES + F.wave, NGW = F.G * NWAVES;
    const int nctx = nrows > ML ? nrows - ML : 0;
    const float* gp = gain + 4 * F.lane;
    for (int w = gw; w < ML / 4; w += NGW) {
        const int r0 = 4 * w, mrow = r0 >> 11;
        const float* sh = mod + (size_t)mrow * MODW + 4 * F.lane;
        f32x4 A[8], S[8], vn[8];
        const float* xr = src_lat + (size_t)r0 * DM + 4 * F.lane;
#pragma unroll
        for (int j = 0; j < 8; ++j) vn[j] = *(const f32x4*)(xr + 256 * j);
#pragma unroll
        for (int j = 0; j < 8; ++j) { A[j] = *(const f32x4*)(gp + 256 * j) * (*(const f32x4*)(sh + DM + 256 * j) + 1.0f); S[j] = *(const f32x4*)(sh + 256 * j); }
#pragma unroll
        for (int i = 0; i < 4; ++i) {
            f32x4 v[8];
#pragma unroll
            for (int j = 0; j < 8; ++j) v[j] = vn[j];
            if (i < 3) {
#pragma unroll
                for (int j = 0; j < 8; ++j) vn[j] = *(const f32x4*)(xr + (size_t)(i + 1) * DM + 256 * j); }
            float ss = 0.f;
#pragma unroll
            for (int j = 0; j < 8; ++j) ss += (v[j].x * v[j].x + v[j].y * v[j].y) + (v[j].z * v[j].z + v[j].w * v[j].w);
            const float rstd = 1.0f / sqrtf(wave_sum(ss) * (1.0f / DM) + EPS);
            bf16* orow = H + (size_t)(r0 + i) * DM + 4 * F.lane;
#pragma unroll
            for (int j = 0; j < 8; ++j) { const f32x4 o = (v[j] * rstd) * A[j] + S[j]; u32x2 wv; wv.x = pkbf(o.x, o.y); wv.y = pkbf(o.z, o.w); *(u32x2*)(orow + 256 * j) = wv; }
        }
    }
    for (int w = gw; w < nctx; w += NGW) {
        const float* xr = src_ctx + (size_t)w * DM + 4 * F.lane;
        const float* sh = mod + (size_t)4 * MODW + 4 * F.lane;
        f32x4 v[8];
#pragma unroll
        for (int j = 0; j < 8; ++j) v[j] = *(const f32x4*)(xr + 256 * j);
        if (NSLAB > 0) {
            const float* sp = slab + (size_t)w * DM + 4 * F.lane; const float* gtp = gate + (size_t)4 * MODW + 4 * F.lane; float* xo = Xc_out + (size_t)w * DM + 4 * F.lane;
#pragma unroll
            for (int j = 0; j < 8; ++j) { f32x4 a = *(const f32x4*)(sp + 256 * j);
#pragma unroll
                for (int sidx = 1; sidx < NSLAB; ++sidx) a += *(const f32x4*)(sp + (size_t)sidx * MC * DM + 256 * j);
                v[j] += *(const f32x4*)(gtp + 256 * j) * gscale * a; *(f32x4*)(xo + 256 * j) = v[j]; }
        }
        float ss = 0.f;
#pragma unroll
        for (int j = 0; j < 8; ++j) ss += (v[j].x * v[j].x + v[j].y * v[j].y) + (v[j].z * v[j].z + v[j].w * v[j].w);
        const float rstd = 1.0f / sqrtf(wave_sum(ss) * (1.0f / DM) + EPS);
        bf16* orow = H + (size_t)(ML + w) * DM + 4 * F.lane;
#pragma unroll
        for (int j = 0; j < 8; ++j) {
            const f32x4 g4 = *(const f32x4*)(gp + 256 * j), s4 = *(const f32x4*)(sh + 256 * j), c4 = *(const f32x4*)(sh + DM + 256 * j);
            const f32x4 o = (v[j] * rstd * g4) * (c4 + 1.0f) + s4;
            u32x2 wv; wv.x = pkbf(o.x, o.y); wv.y = pkbf(o.z, o.w);
            *(u32x2*)(orow + 256 * j) = wv;
        }
    }
}
__device__ __forceinline__ void phase_norm(const Frame& F, const float* src_lat, const float* src_ctx, const float* gain, const float* mod, bf16* H, int nrows,
                                           const float* slab, int nslab, const float* gate, float gscale, float* Xc_out) {
    if (nslab == 8) phase_norm_t<8>(F, src_lat, src_ctx, gain, mod, H, nrows, slab, gate, gscale, Xc_out);
    else if (nslab == 4) phase_norm_t<4>(F, src_lat, src_ctx, gain, mod, H, nrows, slab, gate, gscale, Xc_out);
    else phase_norm_t<0>(F, src_lat, src_ctx, gain, mod, H, nrows, slab, gate, gscale, Xc_out);
}
__device__ __forceinline__ void phase_final(const Frame& F0, const float* X, const float* gain, float* out) {
    const Frame F = refresh(F0);
    const int gw = F.vcu * NWAVES + F.wave, NGW = F.G * NWAVES;
    for (int row = gw; row < ML; row += NGW) {
        const float* xr = X + (size_t)row * DM + 4 * F.lane;
        f32x4 v[8]; float ss = 0.f;
#pragma unroll
        for (int j = 0; j < 8; ++j) { v[j] = *(const f32x4*)(xr + 256 * j); ss += (v[j].x * v[j].x + v[j].y * v[j].y) + (v[j].z * v[j].z + v[j].w * v[j].w); }
        const float rstd = 1.0f / sqrtf(wave_sum(ss) * (1.0f / DM) + EPS);
        float* orow = out + (size_t)row * DM + 4 * F.lane; const float* gp = gain + 4 * F.lane;
#pragma unroll
        for (int j = 0; j < 8; ++j) *(f32x4*)(orow + 256 * j) = v[j] * rstd * *(const f32x4*)(gp + 256 * j);
    }
}

__device__ __forceinline__ void phase_conv(const Frame& F0, const bf16* UCONV, const float* dw, const float* db, const float* lng, const float* lnb, bf16* CONVACT, int nunits) {
    const Frame F = refresh(F0);
    LAS float* WL = (LAS float*)(F.lds + RING_OFF);
    LAS float* red = (LAS float*)(F.lds + RING_OFF + CONVK * CDIM * 4);
    __syncthreads();
    for (int i = F.tid; i < CONVK * CDIM / 4; i += NWAVES * 64) *(LAS f32x4*)(WL + 4 * i) = *(const f32x4*)(dw + 4 * i);
    __syncthreads();
    const int cg = F.tid & 127, q = F.tid >> 7, ch = 8 * cg;
    const bool vert_wave = (F.wave & 1) != 0;
    f32x4 bias[2], g2[2], b2[2];
#pragma unroll
    for (int h = 0; h < 2; ++h) { bias[h] = *(const f32x4*)(db + ch + 4 * h); g2[h] = *(const f32x4*)(lng + ch + 4 * h); b2[h] = *(const f32x4*)(lnb + ch + 4 * h); }
    const LAS float* wl = WL + ch;
    for (int unit = F.vcu; unit < nunits; unit += F.G) {
        const bool is_ctx = unit >= 512;
        const int bb = unit >> 7, r0 = ((unit >> 4) & 7) * 4, w0 = (unit & 15) * 4;
        const int tokc = ML + (unit - 512) * 16;
        int lbase, lstride, lo, len;
        if (is_ctx) { const int base = ML + ((tokc - ML) & ~255); lbase = base; lstride = 1; lo = (tokc - base) + 4 * q - 15; len = 256; }
        else if (!vert_wave) { lbase = bb * SEQ + (r0 + q) * 64; lstride = 1; lo = w0 - 15; len = 64; }
        else { lbase = bb * SEQ + w0 + q; lstride = 64; lo = r0 - 15; len = 32; }
        const bf16* up = UCONV + ch;
        f32x4 o[4][2];
#pragma unroll
        for (int i = 0; i < 4; ++i) { o[i][0] = bias[0]; o[i][1] = bias[1]; }
        f32x4 wr[4][2];
#pragma unroll
        for (int j = 0; j < 34; ++j) {
            const int pos = lo + j; const bool ok = pos >= 0 && pos < len; const int pc = pos < 0 ? 0 : (pos >= len ? len - 1 : pos);
            const pg8::u32x4 xw = *(const pg8::u32x4*)(up + (size_t)(lbase + pc * lstride) * CDIM);
            const float m = ok ? 1.f : 0.f;
            const f32x4 x0 = pg8::bf4_lo(xw, 0) * m, x1 = pg8::bf4_lo(xw, 1) * m;
            if (j < CONVK) { wr[j & 3][0] = *(const LAS f32x4*)(wl + j * CDIM); wr[j & 3][1] = *(const LAS f32x4*)(wl + j * CDIM + 4); }
#pragma unroll
            for (int i = 0; i < 4; ++i) { const int k = j - i; if (k >= 0 && k < CONVK) { o[i][0] += wr[k & 3][0] * x0; o[i][1] += wr[k & 3][1] * x1; } }
        }
        float v[8];
#pragma unroll
        for (int i = 0; i < 4; ++i) {
            v[i] = (o[i][0][0] + o[i][0][1]) + (o[i][0][2] + o[i][0][3]) + (o[i][1][0] + o[i][1][1]) + (o[i][1][2] + o[i][1][3]);
            const f32x4 s0 = o[i][0] * o[i][0], s1 = o[i][1] * o[i][1];
            v[4 + i] = (s0[0] + s0[1]) + (s0[2] + s0[3]) + (s1[0] + s1[1]) + (s1[2] + s1[3]);
        }
#define BFLY(HALF, BIT) { const bool hi = (F.lane & BIT) != 0; _Pragma("unroll") for (int i = 0; i < HALF; ++i) { const float send = hi ? v[i] : v[HALF + i], keep = hi ? v[HALF + i] : v[i]; v[i] = keep + __shfl_xor(send, BIT); } }
        BFLY(4, 32) BFLY(2, 16) BFLY(1, 8)
#undef BFLY
        v[0] += __shfl_xor(v[0], 4); v[0] += __shfl_xor(v[0], 2); v[0] += __shfl_xor(v[0], 1);
        if ((F.lane & 7) == 0) red[F.wave * 8 + (F.lane >> 3)] = v[0];
        __syncthreads();
#pragma unroll
        for (int i = 0; i < 4; ++i) {
            const int ha = is_ctx ? (2 * q) * 8 + i : (vert_wave ? (2 * i) * 8 + q : (2 * q) * 8 + i);
            const int va = is_ctx ? (2 * q + 1) * 8 + i : (vert_wave ? (2 * q + 1) * 8 + i : (2 * i + 1) * 8 + q);
            const float mean = (red[ha] + red[va]) * (1.0f / CDIM), var = (red[ha + 4] + red[va + 4]) * (1.0f / CDIM) - mean * mean;
            const float rstd = 1.0f / sqrtf(fmaxf(var, 0.f) + EPS);
            const f32x4 y0 = (o[i][0] - mean) * rstd * g2[0] + b2[0], y1 = (o[i][1] - mean) * rstd * g2[1] + b2[1];
            const int tok = is_ctx ? tokc + 4 * q + i : (vert_wave ? bb * SEQ + (r0 + i) * 64 + w0 + q : bb * SEQ + (r0 + q) * 64 + w0 + i);
            pg8::u32x4 w; w.x = pkbf(y0[0] * sigm(y0[0]), y0[1] * sigm(y0[1])); w.y = pkbf(y0[2] * sigm(y0[2]), y0[3] * sigm(y0[3]));
            w.z = pkbf(y1[0] * sigm(y1[0]), y1[1] * sigm(y1[1])); w.w = pkbf(y1[2] * sigm(y1[2]), y1[3] * sigm(y1[3]));
            *(pg8::u32x4*)(CONVACT + (size_t)tok * CDIM + ch) = w;
        }
        __syncthreads();
    }
    __syncthreads();
}

constexpr int SSM_CH = 288, SSM_NBLK = 18;
__device__ __forceinline__ int ssm_row(int b, int q, int d, int i) {
    const int s = q * SSM_CH + i;
    return s < CTXL ? ML + b * CTXL + (d ? CTXL - 1 - s : s) : b * SEQ + (d ? SEQ - 1 - (s - CTXL) : s - CTXL);
}
constexpr int SSM_RS = 272;
template <bool PASS2>
__device__ __forceinline__ void ssm_task(const Frame& F, int l, int d, int bp, int g, int q, const bf16* SSMIN, f32x2* E, float* Y) {
    const unsigned char* ws = F.ws;
    const int lane = F.lane, jj = lane & 31, half = lane >> 5, ldg = (l * 2 + d) * 64 + g;
    const f32x2* LAM = (const f32x2*)(ws + WS_LAM) + (size_t)ldg * 64;
    const f32x2 lam0 = LAM[jj], lam1 = LAM[32 + jj];
    pg8::bf16x8 bfr[4];
    { const pg8::bf16x8* bop = (const pg8::bf16x8*)(ws + WS_BOP) + (size_t)ldg * 4 * 64 + lane;
#pragma unroll
      for (int nb = 0; nb < 4; ++nb) bfr[nb] = bop[nb * 64]; }
    pg8::bf16x8 cfr[4];
    if (PASS2) { const pg8::bf16x8* cop = (const pg8::bf16x8*)(ws + WS_COP) + (size_t)ldg * 4 * 64 + lane;
#pragma unroll
      for (int ks = 0; ks < 4; ++ks) cfr[ks] = cop[ks * 64]; }
    float h0r = 0.f, h0i = 0.f, h1r = 0.f, h1i = 0.f;
    const int b = 2 * bp + half;
    f32x2* Eb = E + ((size_t)((d * 4 + b) * 64 + g) * 9) * 64;
    if (PASS2) {
        const f32x2* LAMT = (const f32x2*)(ws + WS_LAMT) + (size_t)ldg * 64;
        const f32x2 t0 = LAMT[jj], t1 = LAMT[32 + jj];
        f32x2 e0[7], e1[7];
#pragma unroll
        for (int qq = 0; qq < 7; ++qq) { const int qc = qq < q ? qq : 0; e0[qq] = Eb[qc * 64 + jj]; e1[qq] = Eb[qc * 64 + 32 + jj]; }
#pragma unroll
        for (int qq = 0; qq < 7; ++qq) if (qq < q) {
            const float n0r = t0.x * h0r - t0.y * h0i + e0[qq].x, n0i = t0.x * h0i + t0.y * h0r + e0[qq].y; h0r = n0r; h0i = n0i;
            const float n1r = t1.x * h1r - t1.y * h1i + e1[qq].x, n1i = t1.x * h1i + t1.y * h1r + e1[qq].y; h1r = n1r; h1i = n1i;
        }
    }
    const int iA = lane & 31, halfA = (iA >> 2) & 1, vA = 4 * (iA >> 3) + (iA & 3), bA = 2 * bp + halfA;
    const bf16* ucol = SSMIN + g * 16 + 8 * (lane >> 5);
    LAS unsigned char* img = F.lds + RING_OFF + F.wave * (32 * SSM_RS);
    pg8::bf16x8 a_nxt = *(const pg8::bf16x8*)(ucol + (size_t)ssm_row(bA, q, d, vA) * SDIM);
    for (int blk = 0; blk < SSM_NBLK; ++blk) {
        const pg8::bf16x8 a = a_nxt;
        if (blk + 1 < SSM_NBLK) a_nxt = *(const pg8::bf16x8*)(ucol + (size_t)ssm_row(bA, q, d, (blk + 1) * 16 + vA) * SDIM);
        f32x16 acc[4];
#pragma unroll
        for (int nb = 0; nb < 4; ++nb) { f32x16 z;
#pragma unroll
            for (int e = 0; e < 16; ++e) z[e] = 0.f;
            acc[nb] = __builtin_amdgcn_mfma_f32_32x32x16_bf16(a, bfr[nb], z, 0, 0, 0); }
#pragma unroll
        for (int v = 0; v < 16; ++v) {
            const float n0r = lam0.x * h0r - lam0.y * h0i + acc[0][v], n0i = lam0.x * h0i + lam0.y * h0r + acc[2][v]; h0r = n0r; h0i = n0i;
            const float n1r = lam1.x * h1r - lam1.y * h1i + acc[1][v], n1i = lam1.x * h1i + lam1.y * h1r + acc[3][v]; h1r = n1r; h1i = n1i;
            if (PASS2) { u32x2 w; w.x = pkbf(h0r, h0i); w.y = pkbf(h1r, h1i); *(LAS u32x2*)(img + (half * 16 + v) * SSM_RS + 8 * jj) = w; }
        }
        if (PASS2) {
            LDS_WAIT(); asm volatile("" ::: "memory");
            pg8::f32x4 yacc[2];
#pragma unroll
            for (int tb = 0; tb < 2; ++tb) { yacc[tb] = (pg8::f32x4){0.f, 0.f, 0.f, 0.f};
#pragma unroll
                for (int ks = 0; ks < 4; ++ks) { const pg8::bf16x8 af = *(const LAS pg8::bf16x8*)(img + (tb * 16 + (lane & 15)) * SSM_RS + (32 * ks + 8 * (lane >> 4)) * 2);
                    yacc[tb] = __builtin_amdgcn_mfma_f32_16x16x32_bf16(cfr[ks], af, yacc[tb], 0, 0, 0); } }
            LDS_WAIT(); asm volatile("" ::: "memory");
            const int tk = lane & 15, q4 = lane >> 4;
#pragma unroll
            for (int tb = 0; tb < 2; ++tb) *(pg8::f32x4*)(Y + (size_t)ssm_row(2 * bp + tb, q, d, blk * 16 + tk) * SDIM + g * 16 + 4 * q4) = yacc[tb];
        }
    }
    if (!PASS2) { Eb[q * 64 + jj] = (f32x2){h0r, h0i}; Eb[q * 64 + 32 + jj] = (f32x2){h1r, h1i}; }
}
template <bool PASS2>
__device__ __forceinline__ void phase_ssm(const Frame& F0, int l, const bf16* SSMIN, f32x2* E, float* YF, float* YB, int q_lo, int q_hi) {
    const Frame F = refresh(F0);
    const int gw = F.vcu * NWAVES + F.wave, NGW = F.G * NWAVES, nq = q_hi - q_lo;
    for (int t = gw; t < 256 * nq; t += NGW) {
        const int d = t & 1, bp = (t >> 1) & 1, g = (t >> 2) & 63, q = q_lo + (t >> 8);
        ssm_task<PASS2>(F, l, d, bp, g, q, SSMIN, E, d ? YB : YF);
    }
}
__device__ __forceinline__ void phase_ssm_post(const Frame& F0, const float* YF, const float* YB, const bf16* SSMIN, const float* ssm_d, bf16* SSMACT, int nrows) {
    const Frame F = refresh(F0);
    const size_t n8 = (size_t)nrows * SDIM / 8;
    for (size_t i = (size_t)F.vcu * (NWAVES * 64) + F.tid; i < n8; i += (size_t)F.G * NWAVES * 64) {
        const size_t e = i * 8; const int c = (int)(e & (SDIM - 1));
        const pg8::f32x4 f0 = *(const pg8::f32x4*)(YF + e), f1 = *(const pg8::f32x4*)(YF + e + 4), b0 = *(const pg8::f32x4*)(YB + e), b1 = *(const pg8::f32x4*)(YB + e + 4);
        const pg8::f32x4 d0 = *(const pg8::f32x4*)(ssm_d + c), d1 = *(const pg8::f32x4*)(ssm_d + c + 4);
        const pg8::u32x4 uw = *(const pg8::u32x4*)(SSMIN + e);
        const pg8::f32x4 y0 = f0 + b0 + d0 * pg8::bf4_lo(uw, 0), y1 = f1 + b1 + d1 * pg8::bf4_lo(uw, 1);
        pg8::u32x4 w; w.x = pkbf(gelu_tanh(y0[0]), gelu_tanh(y0[1])); w.y = pkbf(gelu_tanh(y0[2]), gelu_tanh(y0[3])); w.z = pkbf(gelu_tanh(y1[0]), gelu_tanh(y1[1])); w.w = pkbf(gelu_tanh(y1[2]), gelu_tanh(y1[3]));
        *(pg8::u32x4*)(SSMACT + e) = w;
    }
}

constexpr int PH_PER_LAYER = 14, PH_FINAL = 1 + 2 * PH_PER_LAYER, NPHASES = PH_FINAL + 1;
__global__ void __launch_bounds__(NWAVES * 64, 2) fwd_kernel(Args args) {
    extern __shared__ __attribute__((aligned(16))) unsigned char lds[];
    Frame F;
    F.lds = (LAS unsigned char*)lds;
    F.tid = threadIdx.x; F.lane = F.tid & 63; F.wave = __builtin_amdgcn_readfirstlane(F.tid >> 6);
    F.G = gridDim.x; { const int bx = blockIdx.x; F.vcu = (F.G % 8 == 0) ? (bx % 8) * (F.G / 8) + bx / 8 : bx; }
    F.ws = args.ws;
    unsigned char* ws = args.ws;
    gu32* ctl = (gu32*)(ws + WS_CTL);
    volatile LAS unsigned* MISC = (volatile LAS unsigned*)(F.lds + MISC_OFF);
    for (int u = F.tid; u < (LDS_BYTES - LDSCTL_OFF) / 4; u += NWAVES * 64) ((LAS unsigned*)(F.lds + LDSCTL_OFF))[u] = 0u;
    __syncthreads();
    const int lo = args.ph_lo, hi = args.ph_hi;
    XcdBarrier bar; bar.bar = (unsigned*)(ctl + CW_BAR); bar.x = 0; bar.st = nullptr;
    if (hi - lo > 1) bar = xcd_barrier_post((unsigned*)(ctl + CW_BAR), MISC + 8);
#ifndef PHMASK
#define PHMASK 0xFFFFFFFFu
#endif
#define PHON(s) (((PHMASK) >> (s)) & 1u)
#define IN(k) (lo <= (k) && (k) < hi)
#define SEAM(k) do { if (IN((k) + 1)) xcd_barrier(bar); } while (0)

    float* MOD = (float*)(ws + WS_MOD);
    float* X = (float*)(ws + WS_X); bf16* H = (bf16*)(ws + WS_H); bf16* ACT = (bf16*)(ws + WS_ACT);
    bf16* UCONV = (bf16*)(ws + WS_UCONV); bf16* SSMIN = (bf16*)(ws + WS_SSMIN); bf16* GATES = (bf16*)(ws + WS_GATES);
    bf16* CONVACT = (bf16*)(ws + WS_CONVACT); bf16* SSMACT = (bf16*)(ws + WS_SSMACT);
    float* YF = (float*)(ws + WS_YF); float* YB = (float*)(ws + WS_YB); bf16* T1 = (bf16*)(ws + WS_T1); bf16* MIX = (bf16*)(ws + WS_MIX); f32x2* E = (f32x2*)(ws + WS_E); float* SLAB = (float*)(ws + WS_SLAB);

    float* DUMMY = (float*)(ws + WS_END);
    if (PHON(14) && IN(0)) { phase_prologue(F, args); SEAM(0); }

    for (int l = 0; l < 2; ++l) {
        const int pb = 1 + PH_PER_LAYER * l;
        const bool last = (l == 1);
        unsigned char* wl = ws + WS_W + (size_t)l * W_LAYER;
        const float* modl = MOD + (size_t)l * 5 * MODW;
        const float* x_lat = l == 0 ? args.in[0] : X; const float* x_ctx = l == 0 ? args.in[2] : X + (size_t)ML * DM;
        float* Xc = X + (size_t)ML * DM;
        if (PHON(0) && IN(pb + 0)) REP(0) { phase_norm(F, x_lat, x_ctx, args.in[6] + (size_t)l * DM, modl + 0 * DM, H, MT, SLAB, l == 0 ? 0 : 4, MOD + 8 * DM, 0.5f, Xc); SEAM(pb + 0); }
        if (PHON(1) && IN(pb + 1)) REP(1) { pg8::Gemm g{H, (const bf16*)(wl + WO_UP1), MT, 2 * DFF, DM}; pg8::Order S; S.init(MT, 2 * DFF, g.K, F.G, (int)blockIdx.x);
            pg8::EpiSwiGLU Ep{ACT, DFF}; pg8::gemm_phase<pg8::EpiSwiGLU, pg8::Order, true, true>(F.lds + RING_OFF, g, S, Ep); SEAM(pb + 1); }
        if (PHON(2) && IN(pb + 2)) REP(2) { pg8::Gemm g{ACT, (const bf16*)(wl + WO_DN1), MT, DM, DFF}; pg8::Order S; S.init(ML, DM, g.K, F.G, (int)blockIdx.x); S.extra(32, 32, 0, 8, 4);
            pg8::EpiResid Ep{x_lat, x_ctx, rep_ ? DUMMY : X, modl + 2 * DM, 0.5f, rep_ ? DUMMY : SLAB, DFF / 64}; pg8::gemm_phase<pg8::EpiResid, pg8::Order, true, true>(F.lds + RING_OFF, g, S, Ep); SEAM(pb + 2); }
        if (PHON(3) && IN(pb + 3)) REP(3) { phase_norm(F, X, x_ctx, args.in[9] + (size_t)l * DM, modl + 3 * DM, H, MT, SLAB, 4, modl + 2 * DM, 0.5f, Xc); SEAM(pb + 3); }
        if (PHON(4) && IN(pb + 4)) REP(4) { pg8::Gemm g{H, (const bf16*)(wl + WO_IN), MT, NIN, DM}; pg8::Order S;
            if (!last) S.init(MT, NIN, g.K, F.G, (int)blockIdx.x); else { S.init(ML, NIN, g.K, F.G, (int)blockIdx.x); S.extra(16, 32, 8, 4, 1); }
            pg8::EpiProj Ep{UCONV, SSMIN, GATES, args.in[11] + (size_t)l * NIN}; pg8::gemm_phase<pg8::EpiProj, pg8::Order, true, true>(F.lds + RING_OFF, g, S, Ep); SEAM(pb + 4); }
        if (PHON(5) && IN(pb + 5)) REP(5) {
            phase_conv(F, UCONV, args.in[12] + (size_t)l * CONVK * CDIM, args.in[13] + (size_t)l * CDIM, args.in[14] + (size_t)l * CDIM, args.in[15] + (size_t)l * CDIM, CONVACT, last ? 512 : 576);
            phase_ssm<false>(F, l, SSMIN, E, YF, YB, 0, 7);
            SEAM(pb + 5); }
        if (PHON(6) && IN(pb + 6)) REP(6) { phase_ssm<true>(F, l, SSMIN, E, YF, YB, 0, 8); SEAM(pb + 6); }
        if (PHON(7) && IN(pb + 7)) REP(7) { phase_ssm_post(F, YF, YB, SSMIN, args.in[24] + (size_t)l * SDIM, SSMACT, last ? ML : MT); SEAM(pb + 7); }
        const int Mx = last ? ML : MT;
        if (PHON(8) && IN(pb + 8)) REP(8) { pg8::Gemm g{SSMACT, (const bf16*)(wl + WO_GLU), Mx, 2 * DM, SDIM}; pg8::Order S; S.init(Mx, 2 * DM, g.K, F.G, (int)blockIdx.x);
            pg8::EpiGluGate Ep{T1, GATES, args.in[26] + (size_t)l * 2 * DM}; pg8::gemm_phase<pg8::EpiGluGate, pg8::Order, true, true>(F.lds + RING_OFF, g, S, Ep); SEAM(pb + 8); }
        if (PHON(9) && IN(pb + 9)) REP(9) { pg8::Gemm g{CONVACT, (const bf16*)(wl + WO_CO), Mx, DM, CDIM}; pg8::Order S; S.init(Mx, DM, g.K, F.G, (int)blockIdx.x);
            pg8::EpiConvMix Ep{MIX, GATES, T1}; pg8::gemm_phase<pg8::EpiConvMix, pg8::Order, true, true>(F.lds + RING_OFF, g, S, Ep); SEAM(pb + 9); }
        if (PHON(10) && IN(pb + 10)) REP(10) { pg8::Gemm g{MIX, (const bf16*)(wl + WO_OUT), Mx, DM, DM}; pg8::Order S; S.init(ML, DM, g.K, F.G, (int)blockIdx.x); if (!last) S.extra(32, 32, 0, 8, 8);
            pg8::EpiResid Ep{X, Xc, rep_ ? DUMMY : X, modl + 5 * DM, 1.0f, rep_ ? DUMMY : SLAB, DM / 64}; pg8::gemm_phase<pg8::EpiResid, pg8::Order, true, true>(F.lds + RING_OFF, g, S, Ep); SEAM(pb + 10); }
        if (PHON(11) && IN(pb + 11)) REP(11) { phase_norm(F, X, Xc, args.in[28] + (size_t)l * DM, modl + 6 * DM, H, Mx, SLAB, last ? 0 : 8, modl + 5 * DM, 1.0f, Xc); SEAM(pb + 11); }
        if (PHON(12) && IN(pb + 12)) REP(12) { pg8::Gemm g{H, (const bf16*)(wl + WO_UP2), Mx, 2 * DFF, DM}; pg8::Order S; S.init(Mx, 2 * DFF, g.K, F.G, (int)blockIdx.x);
            pg8::EpiSwiGLU Ep{ACT, DFF}; pg8::gemm_phase<pg8::EpiSwiGLU, pg8::Order, true, true>(F.lds + RING_OFF, g, S, Ep); SEAM(pb + 12); }
        if (PHON(13) && IN(pb + 13)) REP(13) { pg8::Gemm g{ACT, (const bf16*)(wl + WO_DN2), Mx, DM, DFF}; pg8::Order S; S.init(ML, DM, g.K, F.G, (int)blockIdx.x); if (!last) S.extra(32, 32, 0, 8, 4);
            pg8::EpiResid Ep{X, Xc, rep_ ? DUMMY : X, modl + 8 * DM, 0.5f, rep_ ? DUMMY : SLAB, DFF / 64}; pg8::gemm_phase<pg8::EpiResid, pg8::Order, true, true>(F.lds + RING_OFF, g, S, Ep); SEAM(pb + 13); }
    }
    if (PHON(15) && IN(PH_FINAL)) phase_final(F, X, args.in[31], args.out);
#undef IN
#undef SEAM
}

extern "C" void kernel_launch(void* const* d_in, const int* in_sizes, int n_in, void* d_out, int out_size, void* d_ws, size_t ws_size, hipStream_t stream) {
    static int grid = 0;
    if (grid == 0) {
        if (n_in != 32 || in_sizes[0] != ML * DM || out_size != ML * DM || ws_size < WS_END) { fprintf(stderr, "kernel_launch: unexpected shapes (n_in %d, in0 %d, out %d, ws %zu); nothing launched\n", n_in, n_in > 0 ? in_sizes[0] : -1, out_size, ws_size); grid = -1; return; }
        int dev = 0, cus = 0, per_cu = 0;
        if (hipGetDevice(&dev) != hipSuccess || hipDeviceGetAttribute(&cus, hipDeviceAttributeMultiprocessorCount, dev) != hipSuccess) { grid = -1; return; }
        if (hipFuncSetAttribute((const void*)fwd_kernel, hipFuncAttributeMaxDynamicSharedMemorySize, LDS_BYTES) != hipSuccess) { fprintf(stderr, "kernel_launch: hipFuncSetAttribute failed\n"); grid = -1; return; }
        if (hipOccupancyMaxActiveBlocksPerMultiprocessor(&per_cu, (const void*)fwd_kernel, NWAVES * 64, LDS_BYTES) != hipSuccess || per_cu < 1) fprintf(stderr, "kernel_launch: occupancy query reports %d blocks per CU\n", per_cu);
        (void)hipGetLastError();
        grid = cus;
    }
    if (grid < 0) return;
    if (hipMemsetAsync((char*)d_ws + WS_CTL, 0, ZERO_BYTES, stream) != hipSuccess) { fprintf(stderr, "kernel_launch: memset failed\n"); return; }
    Args a{};
    for (int i = 0; i < 32; ++i) a.in[i] = (const float*)d_in[i];
    a.out = (float*)d_out; a.ws = (unsigned char*)d_ws;
#if MK_PER_PHASE
    for (int p = 0; p < NPHASES; ++p) { a.ph_lo = p; a.ph_hi = p + 1; hipLaunchKernelGGL(fwd_kernel, dim3(grid), dim3(NWAVES * 64), LDS_BYTES, stream, a); }
#else
    a.ph_lo = 0; a.ph_hi = NPHASES; hipLaunchKernelGGL(fwd_kernel, dim3(grid), dim3(NWAVES * 64), LDS_BYTES, stream, a);
#endif
    const hipError_t le = hipPeekAtLastError();
    if (le != hipSuccess) fprintf(stderr, "kernel_launch: launch failed: %s\n", hipGetErrorName(le));
}
```
